# Optimizing an MI355X kernel written in HIP

```python
import math
import jax, jax.numpy as jnp
from jax import lax
import numpy as np

D_MODEL = 1024
BATCH = 2
SEQ = 8192
DEPTH = 2

D_MIX = D_MODEL
LRU_WIDTH = D_MIX // 4
LRU_BLOCKS = 4
LRU_CONV = 4
LRU_C = 8.0
HG_HEADS = 4
HG_DK = 64
HG_DV = 64
HG_CHUNK = 64
ATT_HEADS = 8
ATT_HD = 64
MOBA_BLOCK = 256
MOBA_TOPK = 3
Q_BLOCK = 64
D_FF = 4 * D_MODEL
EPS = 1e-6
NEG = -1e30
TINY = 1e-30

SPLITS = (LRU_WIDTH, LRU_WIDTH,
          HG_HEADS * HG_DK, HG_HEADS * HG_DK, HG_HEADS * HG_DV, HG_HEADS * HG_DV,
          ATT_HEADS * ATT_HD, ATT_HEADS * ATT_HD, ATT_HEADS * ATT_HD)
D_IN = sum(SPLITS)
D_OUT_CAT = LRU_WIDTH + HG_HEADS * HG_DV + ATT_HEADS * ATT_HD

kernel_name = "hybrid_rglru_hgrn2_moba_parallel_heads"


def rms_norm(x, g):
    xf = x.astype(jnp.float32)
    y = xf * lax.rsqrt(jnp.mean(xf * xf, axis=-1, keepdims=True) + EPS)
    return (y * g.astype(jnp.float32)).astype(x.dtype)


def rglru_group(xb, yb, conv_w, conv_b, wa, ba, wx, bx, lam):
    Bn, S, W = xb.shape
    xc = lax.conv_general_dilated(
        xb, conv_w.reshape(LRU_CONV, 1, W).astype(xb.dtype), window_strides=(1,),
        padding=[(LRU_CONV - 1, 0)], dimension_numbers=('NWC', 'WIO', 'NWC'),
        feature_group_count=W) + conv_b.astype(xb.dtype)
    xg = xc.reshape(Bn, S, LRU_BLOCKS, W // LRU_BLOCKS)
    r = jax.nn.sigmoid(jnp.einsum('bsgi,gij->bsgj', xg, wa).reshape(Bn, S, W).astype(jnp.float32)
                       + ba.astype(jnp.float32))
    i = jax.nn.sigmoid(jnp.einsum('bsgi,gij->bsgj', xg, wx).reshape(Bn, S, W).astype(jnp.float32)
                       + bx.astype(jnp.float32))
    log_a = -LRU_C * r * jax.nn.softplus(-lam.astype(jnp.float32))
    a = jnp.exp(log_a)
    u = jnp.sqrt(-jnp.expm1(2.0 * log_a)) * (i * xc.astype(jnp.float32))

    def combine(c1, c2):
        a1, b1 = c1
        a2, b2 = c2
        return a1 * a2, a2 * b1 + b2

    _, h = lax.associative_scan(combine, (a, u), axis=1)
    return (h * jax.nn.gelu(yb.astype(jnp.float32))).astype(xb.dtype)


def hgrn2_group(q, f, i, g, lb, norm_w):
    Bn, S, _ = q.shape
    nc = S // HG_CHUNK
    lb = lb.astype(jnp.float32)
    fpre = f.astype(jnp.float32)
    log_f = jnp.logaddexp(jnp.log(jnp.maximum(lb, TINY)), jnp.log1p(-lb) + jax.nn.log_sigmoid(fpre))
    k = (1.0 - lb) * jax.nn.sigmoid(-fpre)
    qs = jax.nn.silu(q.astype(jnp.float32))

    def heads(t, d):
        return t.astype(jnp.float32).reshape(Bn, nc, HG_CHUNK, HG_HEADS, d).transpose(1, 0, 3, 2, 4)

    qh, kh, lfh, vh = heads(qs, HG_DK), heads(k, HG_DK), heads(log_f, HG_DK), heads(i, HG_DV)
    mask = jnp.tril(jnp.ones((HG_CHUNK, HG_CHUNK), dtype=bool))

    def step(state, inp):
        qc, kc, lfc, vc = inp
        b = jnp.cumsum(lfc, axis=2)
        diff = b[:, :, :, None, :] - b[:, :, None, :, :]
        decay = jnp.exp(jnp.where(mask[:, :, None], diff, NEG))
        att = jnp.einsum('bhtd,bhsd,bhtsd->bhts', qc, kc, decay)
        o = jnp.einsum('bhts,bhse->bhte', att, vc) + jnp.einsum('bhtd,bhde->bhte', qc * jnp.exp(b), state)
        b_last = b[:, :, -1:, :]
        new_state = jnp.exp(b_last[:, :, 0, :])[..., None] * state + \
            jnp.einsum('bhsd,bhse->bhde', kc * jnp.exp(b_last - b), vc)
        return new_state, o

    s0 = jnp.zeros((Bn, HG_HEADS, HG_DK, HG_DV), jnp.float32)
    _, o = lax.scan(step, s0, (qh, kh, lfh, vh))
    o = o.transpose(1, 0, 3, 2, 4).reshape(Bn, S, HG_HEADS, HG_DV)
    o = rms_norm(o, norm_w) * jax.nn.silu(g.reshape(Bn, S, HG_HEADS, HG_DV).astype(jnp.float32))
    return o.reshape(Bn, S, HG_HEADS * HG_DV).astype(q.dtype)


def moba_group(cq, ck, cv):
    Bn, S, _ = cq.shape
    H, hd = ATT_HEADS, ATT_HD
    s_pad = -(-S // MOBA_BLOCK) * MOBA_BLOCK
    pad = s_pad - S

    def heads(t):
        t = t.reshape(Bn, S, H, hd).transpose(0, 2, 1, 3)
        return jnp.pad(t, ((0, 0), (0, 0), (0, pad), (0, 0)))

    q, k, v = heads(cq), heads(ck), heads(cv)
    nblk = s_pad // MOBA_BLOCK
    topk = min(MOBA_TOPK, nblk)
    kb = k.reshape(Bn, H, nblk, MOBA_BLOCK, hd)
    vb = v.reshape(Bn, H, nblk, MOBA_BLOCK, hd)
    kmean = jnp.mean(kb.astype(jnp.float32), axis=3).astype(k.dtype)
    scale = 1.0 / math.sqrt(hd)
    slopes = jnp.asarray(2.0 ** (-8.0 * np.arange(1, H + 1) / H), dtype=jnp.float32)
    nq = s_pad // Q_BLOCK
    qs = q.reshape(Bn, H, nq, Q_BLOCK, hd).transpose(2, 0, 1, 3, 4)
    bi = jnp.arange(Bn)[:, None, None, None]
    hi = jnp.arange(H)[None, :, None, None]
    blk_pos = jnp.arange(MOBA_BLOCK)

    def step(args):
        qi, q_blk = args
        t = qi * Q_BLOCK + jnp.arange(Q_BLOCK)
        j = (qi * Q_BLOCK) // MOBA_BLOCK
        gate = jnp.einsum('bhqd,bhnd->bhqn', q_blk, kmean).astype(jnp.float32)
        gate = jnp.where(jnp.arange(nblk) < j, gate, NEG)
        _, sel = lax.top_k(gate, topk)
        valid = jnp.arange(topk) < j
        ksel = kb[bi, hi, sel]
        vsel = vb[bi, hi, sel]
        s_sel = jnp.einsum('bhqd,bhqkld->bhqkl', q_blk, ksel).astype(jnp.float32) * scale
        pos_sel = sel[..., None] * MOBA_BLOCK + blk_pos
        s_sel = s_sel - slopes[:, None, None, None] * (t[:, None, None] - pos_sel).astype(jnp.float32)
        s_sel = jnp.where(valid[:, None], s_sel, NEG)
        k_own = lax.dynamic_slice_in_dim(kb, j, 1, axis=2)[:, :, 0]
        v_own = lax.dynamic_slice_in_dim(vb, j, 1, axis=2)[:, :, 0]
        s_own = jnp.einsum('bhqd,bhld->bhql', q_blk, k_own).astype(jnp.float32) * scale
        rel = t[:, None] - (j * MOBA_BLOCK + blk_pos)[None, :]
        s_own = jnp.where(rel >= 0, s_own - slopes[:, None, None] * rel.astype(jnp.float32), NEG)
        scores = jnp.concatenate([s_own, s_sel.reshape(Bn, H, Q_BLOCK, topk * MOBA_BLOCK)], axis=-1)
        p = jax.nn.softmax(scores, axis=-1).astype(v.dtype)
        p_own = p[..., :MOBA_BLOCK]
        p_sel = p[..., MOBA_BLOCK:].reshape(Bn, H, Q_BLOCK, topk, MOBA_BLOCK)
        out = jnp.einsum('bhql,bhld->bhqd', p_own, v_own) + jnp.einsum('bhqkl,bhqkld->bhqd', p_sel, vsel)
        return out.astype(v.dtype)

    o = lax.map(step, (jnp.arange(nq), qs))
    o = o.transpose(1, 2, 0, 3, 4).reshape(Bn, H, s_pad, hd)[:, :, :S]
    return o.transpose(0, 2, 1, 3).reshape(Bn, S, H * hd)


def setup_inputs(seed: int = 0) -> dict:
    key = jax.random.key(seed)
    ks = jax.random.split(key, 20)
    f32 = jnp.float32
    L = DEPTH
    nrm = lambda k, shape, fan: jax.random.normal(k, shape, f32) * (fan ** -0.5)
    gain = lambda k, shape: 1.0 + 0.05 * jax.random.normal(k, shape, f32)
    bw = LRU_WIDTH // LRU_BLOCKS
    u = jax.random.uniform(ks[10], (L, LRU_WIDTH), f32, 0.9, 0.999)
    a_base = u ** (1.0 / LRU_C)
    lam = jnp.log(a_base) - jnp.log1p(-a_base)
    return {
        "x": jax.random.normal(ks[0], (BATCH, SEQ, D_MODEL), f32),
        "w_in": nrm(ks[1], (L, D_MODEL, D_IN), D_MODEL),
        "w_out": nrm(ks[2], (L, D_OUT_CAT, D_MODEL), D_OUT_CAT),
        "norm_mix": gain(ks[3], (L, D_MODEL)),
        "norm_mlp": gain(ks[4], (L, D_MODEL)),
        "lru_conv_w": nrm(ks[5], (L, LRU_CONV, LRU_WIDTH), LRU_CONV),
        "lru_conv_b": 0.01 * jax.random.normal(ks[6], (L, LRU_WIDTH), f32),
        "lru_wa": nrm(ks[7], (L, LRU_BLOCKS, bw, bw), bw),
        "lru_ba": 0.01 * jax.random.normal(ks[8], (L, LRU_WIDTH), f32),
        "lru_wx": nrm(ks[9], (L, LRU_BLOCKS, bw, bw), bw),
        "lru_bx": 0.01 * jax.random.normal(ks[11], (L, LRU_WIDTH), f32),
        "lru_lambda": lam,
        "hg_lower_bounds": 0.1 * jax.random.normal(ks[12], (L, HG_HEADS * HG_DK), f32),
        "hg_norm_w": gain(ks[13], (L, HG_DV)),
        "lru_out_norm": gain(ks[14], (L, LRU_WIDTH)),
        "att_out_norm": gain(ks[15], (L, ATT_HEADS * ATT_HD)),
        "w_ff1": nrm(ks[16], (L, D_MODEL, D_FF), D_MODEL),
        "w_ff2": nrm(ks[17], (L, D_FF, D_MODEL), D_FF),
        "norm_final": gain(ks[18], (D_MODEL,)),
    }


def reference(x, w_in, w_out, norm_mix, norm_mlp, lru_conv_w, lru_conv_b, lru_wa, lru_ba, lru_wx, lru_bx,
              lru_lambda, hg_lower_bounds, hg_norm_w, lru_out_norm, att_out_norm, w_ff1, w_ff2, norm_final):
    lb_soft = jax.nn.softmax(hg_lower_bounds.astype(jnp.float32), axis=0)
    lower_bounds = jnp.cumsum(lb_soft, axis=0) - lb_soft[0]
    split_at = np.cumsum(SPLITS)[:-1].tolist()
    for l in range(DEPTH):
        h = rms_norm(x, norm_mix[l])
        z = jnp.einsum('bsd,de->bse', h, w_in[l])
        a_x, a_y, b_q, b_f, b_i, b_g, c_q, c_k, c_v = jnp.split(z, split_at, axis=-1)
        ya = rglru_group(a_x, a_y, lru_conv_w[l], lru_conv_b[l], lru_wa[l], lru_ba[l],
                         lru_wx[l], lru_bx[l], lru_lambda[l])
        yb = hgrn2_group(b_q, b_f, b_i, b_g, lower_bounds[l], hg_norm_w[l])
        yc = moba_group(c_q, c_k, c_v)
        y = jnp.concatenate([rms_norm(ya, lru_out_norm[l]), yb.astype(x.dtype),
                             rms_norm(yc, att_out_norm[l])], axis=-1)
        x = x + jnp.einsum('bse,ed->bsd', y, w_out[l])
        h = rms_norm(x, norm_mlp[l])
        u = jnp.square(jax.nn.relu(jnp.einsum('bsd,df->bsf', h, w_ff1[l])))
        x = x + jnp.einsum('bsf,fd->bsd', u, w_ff2[l])
    return rms_norm(x, norm_final)
```

```cpp
#include <hip/hip_runtime.h>
#include <hip/hip_bf16.h>
#include <cstdio>
#include <cstdint>
#include <cmath>
namespace pg8 {
#define PG8_LAS __attribute__((address_space(3)))
typedef unsigned short bf16_t;
typedef short bf16x8 __attribute__((ext_vector_type(8)));
typedef float f32x4 __attribute__((ext_vector_type(4)));
typedef unsigned u32x4 __attribute__((ext_vector_type(4)));
constexpr int BM = 256, BK = 64, HALF = 128, HTB = HALF * BK * 2  , STAGE_BYTES = 8 * HTB, NXCD = 8, WGM = 8;

__host__ __device__ __forceinline__ int lds_byte(int r, int c) { const int st = (r >> 4) * 2 + (c >> 5), rr = r & 15, cc = c & 31, ob = rr * 64 + cc * 2; return st * 1024 + (ob ^ (((ob >> 9) & 1) << 5)); }
__host__ __device__ __forceinline__ void stage_rc(int b, int& R, int& C) { const int st = b / 1024, sb = b % 1024, swz = sb ^ (((sb >> 9) & 1) << 5); R = (st >> 1) * 16 + swz / 64; C = (st & 1) * 32 + (swz % 64) / 2; }
__host__ __device__ __forceinline__ int perm32(int rho) { const int n = rho >> 4, i = rho & 15; return 8 * (i >> 2) + 4 * n + (i & 3); }

struct Unit { int pm, pn; };
struct Gemm { const bf16_t* A; const bf16_t* Bt; int M, N, K; };

struct StaticOrder {
    int nM, nN, nwg, G, c;
    __host__ __device__ void init(int M, int N, int G_, int c_) { nM = M / BM; nN = N / BM; nwg = nM * nN; G = G_; c = c_; }
    __host__ __device__ bool next(int i, Unit& u) const {
        const long L = (long)i * G + c; if (L >= nwg) return false;
        int wgid = (int)L; { const int q = nwg / NXCD, r = nwg % NXCD, xcd = wgid % NXCD, off = wgid / NXCD; wgid = (xcd < r ? xcd * (q + 1) : r * (q + 1) + (xcd - r) * q) + off; }
        const int nig = WGM * nN, gid = wgid / nig, fm = gid * WGM, gsz = (nM - fm) < WGM ? (nM - fm) : WGM;
        u.pm = fm + ((wgid % nig) % gsz); u.pn = (wgid % nig) / gsz; return true;
    }
    __device__ __forceinline__ void a_ready(const Unit&) const {}
    __device__ __forceinline__ void done(const Unit&) const {}
};
__device__ __forceinline__ unsigned cvt_pk_bf16(float lo, float hi) { unsigned r; asm volatile("v_cvt_pk_bf16_f32 %0, %1, %2" : "=v"(r) : "v"(lo), "v"(hi)); return r; }
typedef float f32x2 __attribute__((ext_vector_type(2)));
typedef unsigned u32x2 __attribute__((ext_vector_type(2)));
template <int ACT> struct EpiScale {
    static constexpr bool PERM = true, AFTER_DRAIN = false;
    bf16_t* O; int ldc; const float* ssq; float inv_k, eps; int sc_lo, sc_hi; float sc;
    __device__ __forceinline__ void operator()(const f32x4 (&acc)[2][2][4][2], const Unit& u, int wr, int wc, int fr, int fq) const {
        const int row0 = u.pm * BM + wr * 64 + fr; const int colt = u.pn * BM;
        const float cs = (colt >= sc_lo && colt < sc_hi) ? sc : 1.f;
        const int col0 = colt + wc * 32 + 8 * fq;
#pragma unroll
        for (int ai = 0; ai < 2; ++ai)
#pragma unroll
            for (int m = 0; m < 4; ++m) { const int row = row0 + ai * HALF + m * 16;
                const f32x4 s4 = *(const f32x4*)(ssq + (size_t)row * 4);
                const float rs = rsqrtf(((s4[0] + s4[1]) + (s4[2] + s4[3])) * inv_k + eps) * cs;
                bf16_t* rowp = O + (size_t)row * ldc + col0;
#pragma unroll
                for (int bj = 0; bj < 2; ++bj) { f32x4 v0 = acc[ai][bj][m][0] * rs, v1 = acc[ai][bj][m][1] * rs;
                    if (ACT == 1) {
#pragma unroll
                        for (int e = 0; e < 4; ++e) { const float a0 = fmaxf(v0[e], 0.f), a1 = fmaxf(v1[e], 0.f); v0[e] = a0 * a0; v1[e] = a1 * a1; } }
                    u32x4 w; w.x = cvt_pk_bf16(v0[0], v0[1]); w.y = cvt_pk_bf16(v0[2], v0[3]); w.z = cvt_pk_bf16(v1[0], v1[1]); w.w = cvt_pk_bf16(v1[2], v1[3]);
                    *(u32x4*)(rowp + bj * HALF) = w; } }
    }
};
struct EpiRes {
    static constexpr bool PERM = false, AFTER_DRAIN = true;
    const float* base; float* out; bf16_t* xb; float* ssq; int ldc;
    __device__ __forceinline__ void fused(f32x4 (&acc)[2][2][4][2], const Unit& u, int wr, int wc, int fr, int fq, PG8_LAS unsigned char* lds, int wid, int lane) const {
        PG8_LAS float* P = (PG8_LAS float*)lds;
#if defined(DBG_ZACC)
#pragma unroll
        for (int a_ = 0; a_ < 2; ++a_)
#pragma unroll
            for (int b_ = 0; b_ < 2; ++b_)
#pragma unroll
                for (int m_ = 0; m_ < 4; ++m_)
#pragma unroll
                    for (int n_ = 0; n_ < 2; ++n_) acc[a_][b_][m_][n_] = (f32x4){0.f, 0.f, 0.f, 0.f};
#endif
        const int col0 = u.pn * BM + wc * 32 + 4 * fq;
#pragma unroll
        for (int ai = 0; ai < 2; ++ai)
#pragma unroll
            for (int m = 0; m < 4; ++m) { const int r = ai * HALF + wr * 64 + m * 16 + fr; const size_t off = (size_t)(u.pm * BM + r) * ldc + col0; float ps = 0.f;
#pragma unroll
                for (int bj = 0; bj < 2; ++bj)
#pragma unroll
                    for (int n = 0; n < 2; ++n) { const f32x4 bs = *(const f32x4*)(base + off + bj * HALF + n * 16); const f32x4 o = bs + acc[ai][bj][m][n];
                        *(f32x4*)(out + off + bj * HALF + n * 16) = o; ps += (o[0] * o[0] + o[1] * o[1]) + (o[2] * o[2] + o[3] * o[3]);
                        u32x2 w; w.x = cvt_pk_bf16(o[0], o[1]); w.y = cvt_pk_bf16(o[2], o[3]); *(u32x2*)(xb + off + bj * HALF + n * 16) = w; }
                ps += __shfl_xor(ps, 16); ps += __shfl_xor(ps, 32);
                if (fq == 0) P[r * 4 + wc] = ps;
                if (m & 1) asm volatile("" ::: "memory"); }
        __syncthreads();
        const int t = wid * 64 + lane;
        if (t < 256) ssq[(size_t)(u.pm * BM + t) * 4 + u.pn] = (P[t * 4] + P[t * 4 + 1]) + (P[t * 4 + 2] + P[t * 4 + 3]);
    }
};
template <class Epi, class Sched, bool ALIGN_EPI = false, bool SP2 = false>
__device__ __forceinline__ void gemm_phase(PG8_LAS unsigned char* lds, const Gemm g, const Sched& S, const Epi& E) {
    int tid_l = threadIdx.x; asm volatile("" : "+v"(tid_l));
    const int tid = tid_l, wid = __builtin_amdgcn_readfirstlane(tid >> 6), lane = tid & 63, wr = wid >> 2, wc = wid & 3, fr = lane & 15, fq = lane >> 4;
    const int K = g.K, nt = K / BK;
    unsigned voffA[2], voffB[2];
#pragma unroll
    for (int i = 0; i < 2; ++i) { int R, C; stage_rc(tid * 16 + i * 8192, R, C); const int Rb = Epi::PERM ? ((R & ~31) + perm32(R & 31)) : R;
        voffA[i] = (unsigned)(R * K + C) * 2u; voffB[i] = (unsigned)(Rb * K + C) * 2u; }
    const size_t kstep = (size_t)(BK * 2);
    const size_t hstep = (size_t)HALF * K * 2;
    const size_t tstep = 2 * hstep;
    const unsigned ldsw = (unsigned)wid * 1024u;
    const int aoff = lds_byte(wr * 64 + fr, fq * 8), boff = lds_byte(wc * 32 + fr, fq * 8);
#define PG8_SA(b, h) (((b) * 2 + (h)) * HTB)
#define PG8_SB(b, h) ((4 + (b) * 2 + (h)) * HTB)
#define PG8_STAGE(bufoff, gbase, voff) do { _Pragma("unroll") for (int _i = 0; _i < 2; ++_i) \
        __builtin_amdgcn_global_load_lds((const unsigned*)((const char*)(gbase) + (voff)[_i]), (PG8_LAS unsigned*)(lds + (bufoff) + ldsw + _i * 8192), 16, 0, 0); } while (0)
#define PG8_LDA(dst, b, h) do { _Pragma("unroll") for (int m = 0; m < 4; ++m) _Pragma("unroll") for (int k = 0; k < 2; ++k) dst[m][k] = *(const PG8_LAS bf16x8*)(lds + PG8_SA(b, h) + aoff + m * 2048 + k * 1024); } while (0)
#define PG8_LDB(dst, b, h) do { _Pragma("unroll") for (int n = 0; n < 2; ++n) _Pragma("unroll") for (int k = 0; k < 2; ++k) dst[n][k] = *(const PG8_LAS bf16x8*)(lds + PG8_SB(b, h) + boff + n * 2048 + k * 1024); } while (0)
#define PG8_MMA(ai, bj, At, Bt) do { __builtin_amdgcn_s_setprio(1); _Pragma("unroll") for (int m = 0; m < 4; ++m) _Pragma("unroll") for (int n = 0; n < 2; ++n) _Pragma("unroll") for (int k = 0; k < 2; ++k) \
        acc[ai][bj][m][n] = __builtin_amdgcn_mfma_f32_16x16x32_bf16(Bt[n][k], At[m][k], acc[ai][bj][m][n], 0, 0, 0); __builtin_amdgcn_s_setprio(0); } while (0)
#define PG8_WAIT_V(n) asm volatile("s_waitcnt vmcnt(" #n ")" ::: "memory")
#define PG8_WAIT_L(n) asm volatile("s_waitcnt lgkmcnt(" #n ")" ::: "memory")
#define PG8_BAR __builtin_amdgcn_s_barrier()
#define PG8_SCHED __builtin_amdgcn_sched_barrier(0)
    Unit cur, nxt; int ui = 0;
    if (!S.next(0, cur)) return;
    f32x4 acc[2][2][4][2];
#pragma unroll
    for (int a = 0; a < 2; ++a)
#pragma unroll
        for (int b = 0; b < 2; ++b)
#pragma unroll
            for (int m = 0; m < 4; ++m)
#pragma unroll
                for (int n = 0; n < 2; ++n) acc[a][b][m][n] = (f32x4){0.f, 0.f, 0.f, 0.f};
    bf16x8 At[4][2], B0[2][2], B1[2][2];
    const char* cA = (const char*)g.A + (size_t)cur.pm * tstep; const char* cB = (const char*)g.Bt + (size_t)cur.pn * tstep;
    S.a_ready(cur);
    if constexpr (SP2) {
        PG8_STAGE(PG8_SB(0, 0), cB, voffB); PG8_STAGE(PG8_SB(0, 1), cB + hstep, voffB); PG8_STAGE(PG8_SA(0, 0), cA, voffA); PG8_STAGE(PG8_SA(0, 1), cA + hstep, voffA);
        if (wr == 1) PG8_BAR;
        PG8_WAIT_V(2); PG8_BAR;
        PG8_STAGE(PG8_SB(1, 0), cB + kstep, voffB); PG8_STAGE(PG8_SA(1, 0), cA + kstep, voffA); PG8_STAGE(PG8_SB(1, 1), cB + hstep + kstep, voffB);
        PG8_WAIT_V(6); PG8_BAR;
    } else {
        PG8_STAGE(PG8_SB(0, 0), cB, voffB); PG8_STAGE(PG8_SA(0, 0), cA, voffA); PG8_STAGE(PG8_SB(0, 1), cB + hstep, voffB); PG8_STAGE(PG8_SA(0, 1), cA + hstep, voffA);
        if (wr == 1) PG8_BAR;
        PG8_WAIT_V(4); PG8_BAR;
        PG8_STAGE(PG8_SB(1, 0), cB + kstep, voffB); PG8_STAGE(PG8_SA(1, 0), cA + kstep, voffA); PG8_STAGE(PG8_SB(1, 1), cB + hstep + kstep, voffB);
        PG8_WAIT_V(6); PG8_BAR;
    }
    for (;;) {
        const bool has_next = S.next(ui + 1, nxt);
        const char* nA = has_next ? (const char*)g.A + (size_t)nxt.pm * tstep : cA; const char* nB = has_next ? (const char*)g.Bt + (size_t)nxt.pn * tstep : cB;
        for (int t = 0; t < nt; t += 2) {
            const bool last = (t == nt - 2);
            const char* a1 = cA + (size_t)(t + 1) * kstep;
            const char* a2 = last ? nA : cA + (size_t)(t + 2) * kstep; const char* b2 = last ? nB : cB + (size_t)(t + 2) * kstep;
            const char* a3 = a2 + kstep; const char* b3 = b2 + kstep;
            if (last && has_next) S.a_ready(nxt);
            if constexpr (SP2) {
            PG8_LDB(B0, 0, 0); PG8_LDB(B1, 0, 1); PG8_SCHED; PG8_LDA(At, 0, 0); PG8_STAGE(PG8_SA(1, 1), a1 + hstep, voffA);
            PG8_WAIT_V(8); PG8_WAIT_L(0); PG8_BAR; PG8_MMA(0, 0, At, B0); PG8_MMA(0, 1, At, B1); PG8_BAR; PG8_SCHED;
            PG8_LDA(At, 0, 1); PG8_STAGE(PG8_SB(0, 0), b2, voffB); PG8_STAGE(PG8_SB(0, 1), b2 + hstep, voffB); PG8_STAGE(PG8_SA(0, 0), a2, voffA);
            PG8_WAIT_V(8); PG8_WAIT_L(0); PG8_BAR; PG8_MMA(1, 0, At, B0); PG8_MMA(1, 1, At, B1); PG8_BAR; PG8_SCHED;
            PG8_LDB(B0, 1, 0); PG8_LDB(B1, 1, 1); PG8_SCHED; PG8_LDA(At, 1, 0); PG8_STAGE(PG8_SA(0, 1), a2 + hstep, voffA);
            PG8_WAIT_V(8); PG8_WAIT_L(0); PG8_BAR; PG8_MMA(0, 0, At, B0); PG8_MMA(0, 1, At, B1); PG8_BAR; PG8_SCHED;
            PG8_LDA(At, 1, 1); PG8_STAGE(PG8_SB(1, 0), b3, voffB); PG8_STAGE(PG8_SB(1, 1), b3 + hstep, voffB); PG8_STAGE(PG8_SA(1, 0), a3, voffA);
            PG8_WAIT_V(8); PG8_WAIT_L(0); PG8_BAR; PG8_MMA(1, 0, At, B0); PG8_MMA(1, 1, At, B1); PG8_BAR; PG8_SCHED;
            } else {
            PG8_LDB(B0, 0, 0); PG8_SCHED; PG8_LDA(At, 0, 0); PG8_STAGE(PG8_SA(1, 1), a1 + hstep, voffA);
            PG8_WAIT_L(8); PG8_BAR; PG8_WAIT_L(0); PG8_MMA(0, 0, At, B0); PG8_BAR; PG8_SCHED;
            PG8_LDB(B1, 0, 1); PG8_STAGE(PG8_SB(0, 0), b2, voffB);
            PG8_BAR; PG8_WAIT_L(0); PG8_MMA(0, 1, At, B1); PG8_BAR;
            PG8_LDA(At, 0, 1); PG8_STAGE(PG8_SA(0, 0), a2, voffA);
            PG8_BAR; PG8_WAIT_L(0); PG8_MMA(1, 0, At, B0); PG8_BAR; PG8_SCHED;
            PG8_STAGE(PG8_SB(0, 1), b2 + hstep, voffB);
            PG8_WAIT_V(6); PG8_BAR; PG8_MMA(1, 1, At, B1); PG8_BAR;
            PG8_LDB(B0, 1, 0); PG8_SCHED; PG8_LDA(At, 1, 0); PG8_STAGE(PG8_SA(0, 1), a2 + hstep, voffA);
            PG8_WAIT_L(8); PG8_BAR; PG8_WAIT_L(0); PG8_MMA(0, 0, At, B0); PG8_BAR; PG8_SCHED;
            PG8_LDB(B1, 1, 1); PG8_STAGE(PG8_SB(1, 0), b3, voffB);
            PG8_BAR; PG8_WAIT_L(0); PG8_MMA(0, 1, At, B1); PG8_BAR;
            PG8_LDA(At, 1, 1); PG8_STAGE(PG8_SA(1, 0), a3, voffA);
            PG8_BAR; PG8_WAIT_L(0); PG8_MMA(1, 0, At, B0); PG8_BAR; PG8_SCHED;
            PG8_STAGE(PG8_SB(1, 1), b3 + hstep, voffB);
            PG8_WAIT_V(6); PG8_BAR; PG8_MMA(1, 1, At, B1); PG8_BAR;
            }
        }
        if constexpr (ALIGN_EPI) { if (wr == 0) PG8_BAR; }
        if constexpr (!Epi::AFTER_DRAIN) { E(acc, cur, wr, wc, fr, fq); S.done(cur); }
        if (!has_next) break;
#pragma unroll
        for (int a = 0; a < 2; ++a)
#pragma unroll
            for (int b = 0; b < 2; ++b)
#pragma unroll
                for (int m = 0; m < 4; ++m)
#pragma unroll
                    for (int n = 0; n < 2; ++n) acc[a][b][m][n] = (f32x4){0.f, 0.f, 0.f, 0.f};
        cur = nxt; cA = nA; cB = nB; ++ui;
        if constexpr (ALIGN_EPI) { if (wr == 1) PG8_BAR; }
    }
    PG8_WAIT_V(0);
    if constexpr (!ALIGN_EPI) { if (wr == 0) PG8_BAR; }
    PG8_BAR;
    if constexpr (Epi::AFTER_DRAIN) { E.fused(acc, cur, wr, wc, fr, fq, lds, wid, lane); S.done(cur); }
#undef PG8_SA
#undef PG8_SB
#undef PG8_STAGE
#undef PG8_LDA
#undef PG8_LDB
#undef PG8_MMA
#undef PG8_WAIT_V
#undef PG8_WAIT_L
#undef PG8_BAR
#undef PG8_SCHED
}
}

constexpr int NWAVES = 8;
constexpr int BATCH = 2, T = 8192, DM = 1024, M = BATCH * T, DIN = 3072, FF = 4096, DEPTH = 2;
constexpr int Z_AX = 0, Z_AY = 256, Z_BQ = 512, Z_BF = 768, Z_BI = 1024, Z_BG = 1280, Z_CQ = 1536, Z_CK = 2048, Z_CV = 2560;
constexpr int Y_A = 0, Y_B = 256, Y_C = 512;
constexpr float EPS = 1e-6f;
constexpr float LOG2E = 1.4426950408889634f;
constexpr float C2 = 0.125f * LOG2E;
constexpr int NPH = 18;
#ifndef MK_ONE_LAUNCH
#define MK_ONE_LAUNCH 1
#endif

constexpr size_t MiB = 1u << 20, KiB = 1024;
constexpr size_t WS_CTL = 0, CTL_ZERO_BYTES = 64 * KiB;
constexpr size_t WS_SSQ = 1 * MiB;
constexpr size_t WS_KM = 1 * MiB + 256 * KiB;
constexpr size_t WS_SEL = 1 * MiB + 512 * KiB;
constexpr size_t WS_LRUA = 2 * MiB;
constexpr size_t WS_LRUU = 2 * MiB + 512 * KiB;
constexpr size_t WS_LRUC = 3 * MiB;
constexpr size_t WS_HGD = 3 * MiB + 512 * KiB;
constexpr size_t WS_GW = 4 * MiB;
constexpr size_t WS_LB = 4 * MiB + 256 * KiB;
constexpr size_t WS_SP = 4 * MiB + 260 * KiB;
constexpr size_t WS_WIN = 8 * MiB;
constexpr size_t WS_WOUT = 20 * MiB;
constexpr size_t WS_W1 = 24 * MiB;
constexpr size_t WS_W2 = 40 * MiB;
constexpr size_t WS_XB = 56 * MiB;
constexpr size_t WS_HGS = 88 * MiB;
constexpr size_t WS_Z = 104 * MiB;
constexpr size_t WS_Y = 200 * MiB;
constexpr size_t WS_H = 104 * MiB;
constexpr size_t WS_END = 232 * MiB;
constexpr int CW_BAR = 1024;

constexpr int RING_BYTES = 131072, LDSCTL_OFF = RING_BYTES, MISC_OFF = LDSCTL_OFF + 320, LDS_BYTES = 147456;

#define GAS __attribute__((address_space(1)))
#define LAS __attribute__((address_space(3)))
typedef unsigned short bf16;
typedef unsigned v4u __attribute__((ext_vector_type(4)));
typedef float f32x4 __attribute__((ext_vector_type(4)));
typedef short bf16x8 __attribute__((ext_vector_type(8)));
typedef float f32x16 __attribute__((ext_vector_type(16)));
typedef short s16x4 __attribute__((ext_vector_type(4)));
#define RLX_AGENT __ATOMIC_RELAXED, __HIP_MEMORY_SCOPE_AGENT
__device__ __forceinline__ unsigned f2bf(float f) { unsigned u = __builtin_bit_cast(unsigned, f); return (u + 0x7fffu + ((u >> 16) & 1u)) >> 16; }
__device__ __forceinline__ unsigned pk2(float lo, float hi) { return f2bf(lo) | (f2bf(hi) << 16); }
__device__ __forceinline__ float bflo(unsigned u) { return __uint_as_float(u << 16); }
__device__ __forceinline__ float bfhi(unsigned u) { return __uint_as_float(u & 0xffff0000u); }
__device__ __forceinline__ float bf1(bf16 v) { return __uint_as_float((unsigned)v << 16); }
__device__ __forceinline__ void unpack8(const v4u v, float (&f)[8]) { f[0] = bflo(v.x); f[1] = bfhi(v.x); f[2] = bflo(v.y); f[3] = bfhi(v.y); f[4] = bflo(v.z); f[5] = bfhi(v.z); f[6] = bflo(v.w); f[7] = bfhi(v.w); }
__device__ __forceinline__ v4u pack8(const float (&f)[8]) { v4u v; v.x = pk2(f[0], f[1]); v.y = pk2(f[2], f[3]); v.z = pk2(f[4], f[5]); v.w = pk2(f[6], f[7]); return v; }
__device__ __forceinline__ float sigmoidf_(float x) { return 1.f / (1.f + __expf(-x)); }
__device__ __forceinline__ float wave_sum(float v) {
#pragma unroll
    for (int o = 1; o < 64; o <<= 1) v += __shfl_xor(v, o);
    return v;
}
#define XB_TMO      128
#define XB_XCNT(j)  (256  + 64 * (j))
#define XB_XSUB(j)  (1280 + 64 * (j))
#define XB_XGEN(j)  (2304 + 64 * (j))
#define XB_TOP      3328
#define XB_TOPGEN   3392
#define XCD_BAR_WORDS 3456
#define XB_SPIN_CAP (1u << 18)

__device__ __forceinline__ unsigned xb_ld(unsigned* p)              { return __hip_atomic_load(p, __ATOMIC_RELAXED, __HIP_MEMORY_SCOPE_AGENT); }
__device__ __forceinline__ unsigned xb_add(unsigned* p, unsigned v) { return __hip_atomic_fetch_add(p, v, __ATOMIC_RELAXED, __HIP_MEMORY_SCOPE_AGENT); }
__device__ __forceinline__ unsigned xb_xcc_id() { return (unsigned)__builtin_amdgcn_s_getreg((3 << 11) | 20) & 0xFu; }
#define XB_SPIN(cond, bar) do { unsigned _sp = 0; while (cond) { __builtin_amdgcn_s_sleep(1); \
    if ((++_sp & 255u) == 0u) { if (xb_ld(&(bar)[XB_TMO])) break; if (_sp > XB_SPIN_CAP) { atomicAdd(&(bar)[XB_TMO], 1u); break; } } } } while (0)

struct XcdBarrier {
    unsigned* bar; unsigned x;
    volatile LAS unsigned* st;
};

__device__ __forceinline__ XcdBarrier xcd_barrier_post(unsigned* bar, volatile LAS unsigned* st) {
    XcdBarrier b; b.bar = bar; b.x = xb_xcc_id(); b.st = st;
    if (threadIdx.x == 0) (void)xb_add(&bar[XB_XCNT(b.x)], 1u);
    return b;
}
__device__ __forceinline__ void xcd_barrier_complete(unsigned* bar, unsigned x, unsigned& nloc, unsigned& nx) {
    const unsigned G = gridDim.x * gridDim.y * gridDim.z;
    unsigned sum, cnt, mine, sp = 0u;
    for (;;) {
        sum = 0u; cnt = 0u; mine = 0u;
#pragma unroll
        for (unsigned j = 0; j < 16; ++j) { const unsigned c = xb_ld(&bar[XB_XCNT(j)]); sum += c; cnt += (c > 0u) ? 1u : 0u; mine = (j == x) ? c : mine; }
        if (sum == G) break;
        __builtin_amdgcn_s_sleep(1);
        if ((++sp & 255u) == 0u) { if (xb_ld(&bar[XB_TMO])) break; if (sp > XB_SPIN_CAP) { atomicAdd(&bar[XB_TMO], 1u); break; } }
    }
    nloc = mine > 0u ? mine : 1u; nx = cnt > 0u ? cnt : 1u;
}

__device__ __forceinline__ void xcd_barrier(const XcdBarrier& b) {
    asm volatile("s_waitcnt vmcnt(0)" ::: "memory");
    __syncthreads();
    if (threadIdx.x == 0) {
        unsigned* bar = b.bar;
        __builtin_amdgcn_s_waitcnt(0);
        unsigned nloc = b.st[0], nx = b.st[1];
        if (nloc == 0u) { xcd_barrier_complete(bar, b.x, nloc, nx); b.st[0] = nloc; b.st[1] = nx; }
        const unsigned old = xb_add(&bar[XB_XSUB(b.x)], 1u);
        const unsigned gen = old / nloc;
        if (old + 1u == (gen + 1u) * nloc) {
            __builtin_amdgcn_fence(__ATOMIC_RELEASE, "agent");
            asm volatile("s_waitcnt vmcnt(0)" ::: "memory");
            const unsigned og = xb_add(&bar[XB_TOP], 1u);
            const unsigned tg = og / nx;
            if (og + 1u == (tg + 1u) * nx) xb_add(&bar[XB_TOPGEN], 1u);
            else XB_SPIN(xb_ld(&bar[XB_TOPGEN]) == tg, bar);
            __builtin_amdgcn_fence(__ATOMIC_ACQUIRE, "agent");
            xb_add(&bar[XB_XGEN(b.x)], 1u);
            asm volatile("s_waitcnt vmcnt(0)" ::: "memory");
        } else {
            XB_SPIN(xb_ld(&bar[XB_XGEN(b.x)]) == gen, bar);
            __builtin_amdgcn_fence(__ATOMIC_ACQUIRE, "agent");
            asm volatile("s_waitcnt vmcnt(0)" ::: "memory");
        }
    }
    __syncthreads();
}

struct Frame {
    LAS unsigned char* lds;
    int tid, lane, wave, vcu, G;
    const unsigned char* ka;
    unsigned char* ws; float* out;
    __device__ __forceinline__ const float* in(int i) const { const unsigned char* k = ka; asm volatile("" : "+s"(k)); return *(const float* const*)(k + 8 * i); }
#define FIN(name, idx) __device__ __forceinline__ const float* name() const { return in(idx); }
    FIN(x, 0) FIN(w_in, 1) FIN(w_out, 2) FIN(norm_mix, 3) FIN(norm_mlp, 4) FIN(conv_w, 5) FIN(conv_b, 6) FIN(lru_wa, 7) FIN(lru_ba, 8) FIN(lru_wx, 9) FIN(lru_bx, 10) FIN(lru_lam, 11)
    FIN(hg_lb, 12) FIN(hg_nw, 13) FIN(lru_on, 14) FIN(att_on, 15) FIN(w_ff1, 16) FIN(w_ff2, 17) FIN(norm_final, 18)
#undef FIN
#define FWS(type, name, off) __device__ __forceinline__ type* name() const { return (type*)(ws + (off)); }
    FWS(float, SSQ, WS_SSQ) FWS(float, KM, WS_KM) FWS(unsigned, SEL, WS_SEL) FWS(float, LRUA, WS_LRUA) FWS(float, LRUU, WS_LRUU) FWS(float, LRUC, WS_LRUC) FWS(float, HGD, WS_HGD) FWS(float, HGS, WS_HGS)
    FWS(float, LB, WS_LB) FWS(float, SP, WS_SP) FWS(bf16, GW, WS_GW) FWS(bf16, WIN, WS_WIN) FWS(bf16, WOUT, WS_WOUT) FWS(bf16, W1, WS_W1) FWS(bf16, W2, WS_W2) FWS(bf16, XB, WS_XB) FWS(bf16, Z, WS_Z) FWS(bf16, Y, WS_Y) FWS(bf16, H, WS_H)
#undef FWS
};

__device__ __forceinline__ float gain_of(const float* g0, const float* g1, int mode, int k) {
    if (mode == 1 || mode == 2) return g0[k];
    if (mode == 3) return k < 256 ? g0[k] : (k < 512 ? 1.f : g1[k - 512]);
    return 1.f;
}
__device__ __forceinline__ void p0_transpose_item(const Frame& F, const float* W, int K, int N, bf16* WT, LAS float* scr, int item, int lane, int mode, int l) {
    const float* g0 = mode == 1 ? F.norm_mix() + l * DM : (mode == 2 ? F.norm_mlp() + l * DM : F.lru_on() + l * 256); const float* g1 = F.att_on() + l * 512;
    const int nblk = N / 32, kb = item / nblk, nb = item % nblk, k0 = 64 * kb, n0 = 32 * nb;
#pragma unroll 8
    for (int i = 0; i < 32; ++i) { const int kk = 2 * i + (lane >> 5); scr[kk * 33 + (lane & 31)] = W[(size_t)(k0 + kk) * N + n0 + (lane & 31)] * gain_of(g0, g1, mode, k0 + kk); }
    asm volatile("s_waitcnt lgkmcnt(0)" ::: "memory");
    const int c = lane & 7;
#pragma unroll
    for (int j = 0; j < 4; ++j) { const int n = (lane >> 3) + 8 * j; const LAS float* s = scr + (8 * c) * 33 + n;
        v4u o; o.x = pk2(s[0 * 33], s[1 * 33]); o.y = pk2(s[2 * 33], s[3 * 33]); o.z = pk2(s[4 * 33], s[5 * 33]); o.w = pk2(s[6 * 33], s[7 * 33]);
        *(GAS v4u*)(WT + (size_t)(n0 + n) * K + k0 + 8 * c) = o; }
    asm volatile("s_waitcnt lgkmcnt(0)" ::: "memory");
}
__device__ __forceinline__ void p0_prologue(const Frame& F) {
    LAS float* scr = (LAS float*)(F.lds + F.wave * 16384);
    const int gw = F.vcu * NWAVES + F.wave, NGW = F.G * NWAVES;
    constexpr int I_IN = (DM / 64) * (DIN / 32), I_OUT = (DM / 64) * (DM / 32), I_1 = (DM / 64) * (FF / 32), I_2 = (FF / 64) * (DM / 32);
    constexpr int PER_L = I_IN + I_OUT + I_1 + I_2;
    for (int it = gw; it < DEPTH * PER_L; it += NGW) {
        const int l = it / PER_L; int r = it % PER_L;
        if (r < I_IN) { p0_transpose_item(F, F.w_in() + (size_t)l * DM * DIN, DM, DIN, F.WIN() + (size_t)l * DIN * DM, scr, r, F.lane, 1, l); continue; } r -= I_IN;
        if (r < I_OUT) { p0_transpose_item(F, F.w_out() + (size_t)l * DM * DM, DM, DM, F.WOUT() + (size_t)l * DM * DM, scr, r, F.lane, 3, l); continue; } r -= I_OUT;
        if (r < I_1) { p0_transpose_item(F, F.w_ff1() + (size_t)l * DM * FF, DM, FF, F.W1() + (size_t)l * FF * DM, scr, r, F.lane, 2, l); continue; } r -= I_1;
        p0_transpose_item(F, F.w_ff2() + (size_t)l * FF * DM, FF, DM, F.W2() + (size_t)l * DM * FF, scr, r, F.lane, 0, l);
    }
    for (int m = gw; m < M; m += NGW) {
        const GAS f32x4* xr = (const GAS f32x4*)(F.x() + (size_t)m * DM) + F.lane; f32x4 v[4]; float s = 0.f;
#pragma unroll
        for (int j = 0; j < 4; ++j) { v[j] = xr[64 * j]; s += (v[j].x * v[j].x + v[j].y * v[j].y) + (v[j].z * v[j].z + v[j].w * v[j].w); }
        s = wave_sum(s);
        GAS unsigned long long* o8 = (GAS unsigned long long*)(F.XB() + (size_t)m * DM) + F.lane;
#pragma unroll
        for (int j = 0; j < 4; ++j) o8[64 * j] = (unsigned long long)pk2(v[j].x, v[j].y) | ((unsigned long long)pk2(v[j].z, v[j].w) << 32);
        if (F.lane == 0) *(f32x4*)(F.SSQ() + (size_t)m * 4) = (f32x4){s, 0.f, 0.f, 0.f};
    }
    const int gt = F.vcu * 512 + F.tid, NGT = F.G * 512;
    for (int e = gt; e < DEPTH * 2 * 4 * 64 * 64; e += NGT) {
        const int i = e & 63, j = (e >> 6) & 63, g = (e >> 12) & 3, mat = (e >> 14) & 1, l = e >> 15;
        const float* w = mat ? F.lru_wx() : F.lru_wa();
        F.GW()[e] = (bf16)f2bf(w[((size_t)(l * 4 + g) * 64 + i) * 64 + j]);
    }
    for (int e = gt; e < DEPTH * 256; e += NGT) {
        const int l = e >> 8, c = e & 255;
        const float h0 = F.hg_lb()[c], h1 = F.hg_lb()[256 + c], mx = fmaxf(h0, h1), e0 = expf(h0 - mx), e1 = expf(h1 - mx);
        F.LB()[e] = l == 0 ? 0.f : e1 / (e0 + e1);
        const float lam = F.lru_lam()[e]; F.SP()[e] = fmaxf(-lam, 0.f) + log1pf(expf(-fabsf(lam)));
    }
}

constexpr int HS = 68, HS1 = 65;
__device__ __forceinline__ void hg_unit(const Frame& F, int l, int unit, bool fin) {
    const int tid = F.tid;
    const int c = unit & 127, bh = unit >> 7, h = bh & 3, b = bh >> 2;
    const size_t row0 = (size_t)b * T + (size_t)c * 64;
    LAS float* Lq = (LAS float*)F.lds;  LAS float* Lb = Lq + 64 * HS1; LAS float* Lk = Lb + 64 * HS1; LAS float* Lv = Lk + 64 * HS1;
    LAS float* La = Lv + 64 * HS; LAS float* Ls = La + 64 * HS; LAS float* Lx = Ls + 64 * HS;
    __syncthreads();
    {
        const int r = tid >> 3, c8 = (tid & 7) * 8;
        const bf16* zr = F.Z() + (row0 + r) * DIN + h * 64 + c8;
        float q[8], f[8], v[8];
        unpack8(*(const v4u*)(zr + Z_BQ), q); unpack8(*(const v4u*)(zr + Z_BF), f); unpack8(*(const v4u*)(zr + Z_BI), v);
#pragma unroll
        for (int j = 0; j < 8; ++j) {
            const float lb = F.LB()[l * 256 + h * 64 + c8 + j];
            const float fj = f[j];
            const float ls = fj >= 0.f ? -log1pf(__expf(-fj)) : fj - log1pf(__expf(fj));
            const float a1 = __logf(fmaxf(lb, 1e-30f)), a2 = log1pf(-lb) + ls;
            const float lf = fmaxf(a1, a2) + log1pf(__expf(-fabsf(a1 - a2)));
            Lq[r * HS1 + c8 + j] = q[j] * sigmoidf_(q[j]);
            Lb[r * HS1 + c8 + j] = lf;
            Lk[r * HS1 + c8 + j] = (1.f - lb) * sigmoidf_(-fj);
            Lv[r * HS + c8 + j] = v[j];
        }
    }
    __syncthreads();
    {
        const int d = tid & 63, sg = tid >> 6; float run = 0.f;
#pragma unroll
        for (int i = 0; i < 8; ++i) { run += Lb[(sg * 8 + i) * HS1 + d]; Lb[(sg * 8 + i) * HS1 + d] = run; }
        Lx[sg * 64 + d] = run;
        __syncthreads();
        float pre = 0.f;
        for (int s2 = 0; s2 < sg; ++s2) pre += Lx[s2 * 64 + d];
#pragma unroll
        for (int i = 0; i < 8; ++i) Lb[(sg * 8 + i) * HS1 + d] += pre;
    }
    __syncthreads();
    if (!fin) {
        {
            const int r = tid >> 3, c8 = (tid & 7) * 8;
#pragma unroll
            for (int j = 0; j < 8; ++j) Lk[r * HS1 + c8 + j] *= __expf(Lb[63 * HS1 + c8 + j] - Lb[r * HS1 + c8 + j]);
        }
        __syncthreads();
        const int d = tid >> 3, e8 = (tid & 7) * 8; float acc[8];
#pragma unroll
        for (int j = 0; j < 8; ++j) acc[j] = 0.f;
        for (int s = 0; s < 64; ++s) { const float kd = Lk[s * HS1 + d]; const f32x4 v0 = *(const LAS f32x4*)(Lv + s * HS + e8), v1 = *(const LAS f32x4*)(Lv + s * HS + e8 + 4);
            acc[0] += kd * v0[0]; acc[1] += kd * v0[1]; acc[2] += kd * v0[2]; acc[3] += kd * v0[3]; acc[4] += kd * v1[0]; acc[5] += kd * v1[1]; acc[6] += kd * v1[2]; acc[7] += kd * v1[3]; }
        float* hp = F.HGS() + (size_t)unit * 4096 + d * 64 + e8;
        *(f32x4*)hp = (f32x4){acc[0], acc[1], acc[2], acc[3]}; *(f32x4*)(hp + 4) = (f32x4){acc[4], acc[5], acc[6], acc[7]};
        if ((tid & 7) == 0) F.HGD()[unit * 64 + d] = __expf(Lb[63 * HS1 + d]);
        return;
    }
    {
        const int d = tid >> 3, e8 = (tid & 7) * 8; const float* hp = F.HGS() + (size_t)unit * 4096 + d * 64 + e8;
        *(LAS f32x4*)(Ls + d * HS + e8) = *(const f32x4*)hp; *(LAS f32x4*)(Ls + d * HS + e8 + 4) = *(const f32x4*)(hp + 4);
    }
    {
        const int t = tid >> 3, sg = tid & 7, jmax = F.wave;
        float a[8];
#pragma unroll
        for (int j = 0; j < 8; ++j) a[j] = 0.f;
        for (int d = 0; d < 64; ++d) { const float qd = Lq[t * HS1 + d], bt = Lb[t * HS1 + d];
#pragma unroll
            for (int j = 0; j < 8; ++j) if (j <= jmax) { const int s = sg + 8 * j; a[j] += qd * Lk[s * HS1 + d] * __expf(fminf(bt - Lb[s * HS1 + d], 0.f)); } }
#pragma unroll
        for (int j = 0; j < 8; ++j) if (j <= jmax) La[t * HS + sg + 8 * j] = (sg + 8 * j <= t) ? a[j] : 0.f;
    }
    __syncthreads();
    {
        const int r = tid >> 3, c8 = (tid & 7) * 8;
#pragma unroll
        for (int j = 0; j < 8; ++j) Lq[r * HS1 + c8 + j] *= __expf(Lb[r * HS1 + c8 + j]);
    }
    __syncthreads();
    {
        const int t = tid >> 3, e8 = (tid & 7) * 8; float acc[8];
#pragma unroll
        for (int j = 0; j < 8; ++j) acc[j] = 0.f;
        for (int s = 0; s <= t; ++s) { const float a = La[t * HS + s]; const f32x4 v0 = *(const LAS f32x4*)(Lv + s * HS + e8), v1 = *(const LAS f32x4*)(Lv + s * HS + e8 + 4);
            acc[0] += a * v0[0]; acc[1] += a * v0[1]; acc[2] += a * v0[2]; acc[3] += a * v0[3]; acc[4] += a * v1[0]; acc[5] += a * v1[1]; acc[6] += a * v1[2]; acc[7] += a * v1[3]; }
        for (int d = 0; d < 64; ++d) { const float a = Lq[t * HS1 + d]; const f32x4 v0 = *(const LAS f32x4*)(Ls + d * HS + e8), v1 = *(const LAS f32x4*)(Ls + d * HS + e8 + 4);
            acc[0] += a * v0[0]; acc[1] += a * v0[1]; acc[2] += a * v0[2]; acc[3] += a * v0[3]; acc[4] += a * v1[0]; acc[5] += a * v1[1]; acc[6] += a * v1[2]; acc[7] += a * v1[3]; }
        float ss = 0.f;
#pragma unroll
        for (int j = 0; j < 8; ++j) ss += acc[j] * acc[j];
        ss += __shfl_xor(ss, 1); ss += __shfl_xor(ss, 2); ss += __shfl_xor(ss, 4);
        const float rs = rsqrtf(ss * (1.f / 64.f) + EPS);
        float g[8]; unpack8(*(const v4u*)(F.Z() + (row0 + t) * DIN + Z_BG + h * 64 + e8), g);
        const float* nw = F.hg_nw() + l * 64 + e8;
        float o[8];
#pragma unroll
        for (int j = 0; j < 8; ++j) o[j] = acc[j] * rs * nw[j] * (g[j] * sigmoidf_(g[j]));
        *(v4u*)(F.Y() + (row0 + t) * DM + Y_B + h * 64 + e8) = pack8(o);
    }
}

constexpr int XS = 264;
__device__ __forceinline__ int crow(int r, int hi) { return (r & 3) + 8 * (r >> 2) + 4 * hi; }
__device__ __forceinline__ float gelu_tanh(float x) { const float u = 0.7978845608028654f * (x + 0.044715f * x * x * x); const float e = __expf(2.f * u); const float th = 1.f - 2.f / (e + 1.f); return 0.5f * x * (1.f + th); }
__device__ __forceinline__ void lru_unit(const Frame& F, int l, int unit, bool fin) {
    const int tid = F.tid, lane = F.lane, wid = F.wave;
    const int c32 = unit & 255, b = unit >> 8, t0 = c32 * 32; const size_t row0 = (size_t)b * T + t0;
    LAS bf16* Lx = (LAS bf16*)F.lds; LAS float* La = (LAS float*)(F.lds + 32 * XS * 2); LAS float* Lu = La + 32 * 256;
    __syncthreads();
    {
        const int r = tid >> 4, cg = (tid & 15) * 16; float acc[16];
        const float* cb = F.conv_b() + l * 256 + cg; const float* cw = F.conv_w() + (size_t)l * 1024 + cg;
#pragma unroll
        for (int j = 0; j < 16; ++j) acc[j] = cb[j];
#pragma unroll
        for (int k = 0; k < 4; ++k) { const int t = t0 + r - 3 + k;
            if (t >= 0) { const bf16* zr = F.Z() + ((size_t)b * T + t) * DIN + Z_AX + cg; float x0[8], x1[8]; unpack8(*(const v4u*)zr, x0); unpack8(*(const v4u*)(zr + 8), x1);
                const float* w = cw + k * 256;
#pragma unroll
                for (int j = 0; j < 8; ++j) { acc[j] += w[j] * x0[j]; acc[8 + j] += w[8 + j] * x1[j]; } } }
        float a0[8], a1[8];
#pragma unroll
        for (int j = 0; j < 8; ++j) { a0[j] = acc[j]; a1[j] = acc[8 + j]; }
        *(LAS v4u*)(Lx + r * XS + cg) = pack8(a0); *(LAS v4u*)(Lx + r * XS + cg + 8) = pack8(a1);
    }
    __syncthreads();
    {
        const int g = wid >> 1, half = wid & 1, r32 = lane & 31, hi = lane >> 5, chl = half * 32 + r32, ch = g * 64 + chl;
        f32x16 racc, iacc;
#pragma unroll
        for (int r = 0; r < 16; ++r) { racc[r] = 0.f; iacc[r] = 0.f; }
        const bf16* gwa = F.GW() + ((size_t)((l * 2 + 0) * 4 + g) * 64 + chl) * 64; const bf16* gwx = F.GW() + ((size_t)((l * 2 + 1) * 4 + g) * 64 + chl) * 64;
#pragma unroll
        for (int ks = 0; ks < 4; ++ks) {
            const bf16x8 a = *(const LAS bf16x8*)(Lx + r32 * XS + g * 64 + ks * 16 + hi * 8);
            const bf16x8 ba = *(const bf16x8*)(gwa + ks * 16 + hi * 8), bx = *(const bf16x8*)(gwx + ks * 16 + hi * 8);
            racc = __builtin_amdgcn_mfma_f32_32x32x16_bf16(a, ba, racc, 0, 0, 0); iacc = __builtin_amdgcn_mfma_f32_32x32x16_bf16(a, bx, iacc, 0, 0, 0);
        }
        const float bav = F.lru_ba()[l * 256 + ch], bxv = F.lru_bx()[l * 256 + ch], spv = F.SP()[l * 256 + ch];
#pragma unroll
        for (int r = 0; r < 16; ++r) { const int tok = crow(r, hi);
            const float xcv = bf1(Lx[tok * XS + ch]);
            const float rg = sigmoidf_(racc[r] + bav), ig = sigmoidf_(iacc[r] + bxv);
            const float la = -8.f * rg * spv, av = __expf(la), mult = sqrtf(-expm1f(2.f * la));
            La[tok * 256 + ch] = av; Lu[tok * 256 + ch] = mult * ig * xcv; }
    }
    __syncthreads();
    if (tid < 256) {
        const int ch = tid; float hc = fin ? F.LRUC()[unit * 256 + ch] : 0.f, P = 1.f;
#pragma unroll 8
        for (int t = 0; t < 32; ++t) { const float av = La[t * 256 + ch], uv = Lu[t * 256 + ch]; hc = av * hc + uv; P *= av; if (fin) Lu[t * 256 + ch] = hc; }
        if (!fin) { F.LRUA()[unit * 256 + ch] = P; F.LRUU()[unit * 256 + ch] = hc; }
    }
    if (!fin) return;
    __syncthreads();
    {
        const int r = tid >> 4, cg = (tid & 15) * 16; const bf16* zr = F.Z() + (row0 + r) * DIN + Z_AY + cg; float g0[8], g1[8]; unpack8(*(const v4u*)zr, g0); unpack8(*(const v4u*)(zr + 8), g1);
        float v0[8], v1[8], ss = 0.f;
#pragma unroll
        for (int j = 0; j < 8; ++j) { v0[j] = Lu[r * 256 + cg + j] * gelu_tanh(g0[j]); v1[j] = Lu[r * 256 + cg + 8 + j] * gelu_tanh(g1[j]); ss += v0[j] * v0[j] + v1[j] * v1[j]; }
        ss += __shfl_xor(ss, 1); ss += __shfl_xor(ss, 2); ss += __shfl_xor(ss, 4); ss += __shfl_xor(ss, 8);
        const float rs = rsqrtf(ss * (1.f / 256.f) + EPS);
#pragma unroll
        for (int j = 0; j < 8; ++j) { v0[j] *= rs; v1[j] *= rs; }
        bf16* yr = F.Y() + (row0 + r) * DM + Y_A + cg; *(v4u*)yr = pack8(v0); *(v4u*)(yr + 8) = pack8(v1);
    }
}

__device__ __forceinline__ void kmean_unit(const Frame& F, int unit) {
    const int b = unit >> 5, n = unit & 31, col = F.tid; const bf16* zp = F.Z() + ((size_t)b * T + (size_t)n * 256) * DIN + Z_CK + col; float s = 0.f;
#pragma unroll 8
    for (int r = 0; r < 256; ++r) s += bf1(zp[(size_t)r * DIN]);
    F.KM()[((size_t)(b * 8 + (col >> 6)) * 32 + n) * 64 + (col & 63)] = s * (1.f / 256.f);
}
__device__ __forceinline__ void select_unit(const Frame& F, int item) {
    const int hp = item & 3, j = (item >> 2) & 31, b = item >> 7, hsel = F.tid >> 8, h = hp * 2 + hsel, tok = F.tid & 255;
    LAS float* km = (LAS float*)F.lds;
    __syncthreads();
#pragma unroll
    for (int i = 0; i < 8; ++i) { const int e = i * 512 + F.tid, hs = e >> 11, r = e & 2047; km[e] = F.KM()[((size_t)(b * 8 + hp * 2 + hs) * 32) * 64 + r]; }
    __syncthreads();
    const size_t row = (size_t)b * T + (size_t)j * 256 + tok;
    float q[64];
#pragma unroll
    for (int i = 0; i < 8; ++i) { float t8[8]; unpack8(*(const v4u*)(F.Z() + row * DIN + Z_CQ + h * 64 + i * 8), t8);
#pragma unroll
        for (int e = 0; e < 8; ++e) q[i * 8 + e] = t8[e]; }
    float v1 = -INFINITY, v2 = -INFINITY, v3 = -INFINITY; int i1 = -1, i2 = -1, i3 = -1;
    for (int n = 0; n < j; ++n) { const LAS float* kp = km + (hsel * 32 + n) * 64; float g = 0.f;
#pragma unroll
        for (int d = 0; d < 64; d += 4) { const f32x4 kv = *(const LAS f32x4*)(kp + d); g += q[d] * kv[0] + q[d + 1] * kv[1] + q[d + 2] * kv[2] + q[d + 3] * kv[3]; }
        if (g > v1) { v3 = v2; i3 = i2; v2 = v1; i2 = i1; v1 = g; i1 = n; }
        else if (g > v2) { v3 = v2; i3 = i2; v2 = g; i2 = n; }
        else if (g > v3) { v3 = g; i3 = n; } }
    unsigned msk = 0u; if (i1 >= 0) msk |= 1u << i1; if (i2 >= 0) msk |= 1u << i2; if (i3 >= 0) msk |= 1u << i3;
    F.SEL()[row * 8 + h] = msk;
}

__device__ __forceinline__ void hg_scan_item(const Frame& F, int item) {
    const int e = item * 512 + F.tid, seq = e >> 12, de = e & 4095, d = de >> 6; float S = 0.f;
    for (int c0 = 0; c0 < 128; c0 += 16) { float Hc[16], Dc[16];
#pragma unroll
        for (int i = 0; i < 16; ++i) { const int u = seq * 128 + c0 + i; Hc[i] = F.HGS()[(size_t)u * 4096 + de]; Dc[i] = F.HGD()[u * 64 + d]; }
#pragma unroll
        for (int i = 0; i < 16; ++i) { const int u = seq * 128 + c0 + i; F.HGS()[(size_t)u * 4096 + de] = S; S = Dc[i] * S + Hc[i]; } }
}
__device__ __forceinline__ void lru_scan_item(const Frame& F) {
    const int b = F.tid >> 8, ch = F.tid & 255; float cy = 0.f;
    for (int c0 = 0; c0 < 256; c0 += 16) { float A[16], U[16];
#pragma unroll
        for (int i = 0; i < 16; ++i) { const int u = b * 256 + c0 + i; A[i] = F.LRUA()[u * 256 + ch]; U[i] = F.LRUU()[u * 256 + ch]; }
#pragma unroll
        for (int i = 0; i < 16; ++i) { const int u = b * 256 + c0 + i; F.LRUC()[u * 256 + ch] = cy; cy = A[i] * cy + U[i]; } }
}

namespace moba {
typedef LAS const char* lds_cptr;
typedef short v4i16_t __attribute__((ext_vector_type(4)));
constexpr int SLOTB = 8192, LDS_K = 0, LDS_V = 2 * SLOTB, LDS_WS = 4 * SLOTB, LDS_OST = LDS_WS + NWAVES * 256, LDS_FLAG = LDS_OST + NWAVES * 4096;
__device__ __forceinline__ void glds16(const void* gsrc, unsigned lds_dst) { unsigned keep;
    asm volatile("s_mov_b32 %0, m0\n\ts_mov_b32 m0, %2\n\ts_nop 0\n\tglobal_load_lds_dwordx4 %1, off\n\ts_mov_b32 m0, %0" : "=&s"(keep) : "v"(gsrc), "s"(lds_dst) : "memory"); }
typedef float f32x2_t __attribute__((ext_vector_type(2))); typedef __bf16 bf16x2_t __attribute__((ext_vector_type(2)));
__device__ __forceinline__ unsigned cvtpk_s(float lo, float hi) { f32x2_t v = {lo, hi}; bf16x2_t b = __builtin_convertvector(v, bf16x2_t); return __builtin_bit_cast(unsigned, b); }
#define MX3(a, b, c) __builtin_fmaxf(__builtin_fmaxf((a), (b)), (c))
__device__ __forceinline__ float rowmax(const f32x16& p0, const f32x16& p1) {
    float a = MX3(p0[0], p0[1], p1[0]), b = MX3(p0[2], p0[3], p1[1]); a = MX3(a, p1[2], p1[3]);
#pragma unroll
    for (int r = 4; r < 16; r += 4) { a = MX3(a, p0[r], p0[r + 1]); b = MX3(b, p0[r + 2], p0[r + 3]); a = MX3(a, p1[r], p1[r + 1]); b = MX3(b, p1[r + 2], p1[r + 3]); }
    float m = __builtin_fmaxf(a, b); auto rr = __builtin_amdgcn_permlane32_swap(__float_as_uint(m), __float_as_uint(m), false, false);
    return __builtin_fmaxf(__uint_as_float(rr[0]), __uint_as_float(rr[1])); }
#undef MX3
__device__ __forceinline__ void qkt(f32x16& p0, f32x16& p1, lds_cptr kb, const bf16x8* qr, const f32x16& c0) {
#pragma unroll
    for (int d0 = 0; d0 < 4; ++d0) {
        const bf16x8 b0 = *(const LAS bf16x8*)(kb + d0 * 2048), b1 = *(const LAS bf16x8*)(kb + d0 * 2048 + 512);
        if (d0 == 0) { p0 = __builtin_amdgcn_mfma_f32_32x32x16_bf16(b0, qr[0], c0, 0, 0, 0); p1 = __builtin_amdgcn_mfma_f32_32x32x16_bf16(b1, qr[0], c0, 0, 0, 0); }
        else { p0 = __builtin_amdgcn_mfma_f32_32x32x16_bf16(b0, qr[d0], p0, 0, 0, 0); p1 = __builtin_amdgcn_mfma_f32_32x32x16_bf16(b1, qr[d0], p1, 0, 0, 0); } }
}
__device__ __forceinline__ void pv(f32x16* o, int vb, bf16x8 pa0, bf16x8 pa1, bf16x8 pa2, bf16x8 pa3) {
#pragma unroll
    for (int d0 = 0; d0 < 2; ++d0) { s16x4 lo[4], hi[4];
#pragma unroll
        for (int ks = 0; ks < 4; ++ks) {
            asm volatile("ds_read_b64_tr_b16 %0,%1 offset:%c2" : "=&v"(lo[ks]) : "v"(vb), "i"(d0 * 4096 + ks * 1024) : "memory");
            asm volatile("ds_read_b64_tr_b16 %0,%1 offset:%c2" : "=&v"(hi[ks]) : "v"(vb), "i"(d0 * 4096 + ks * 1024 + 512) : "memory"); }
        asm volatile("s_waitcnt lgkmcnt(0)" ::: "memory"); __builtin_amdgcn_sched_barrier(0);
#define PK(k) (bf16x8){lo[k][0], lo[k][1], lo[k][2], lo[k][3], hi[k][0], hi[k][1], hi[k][2], hi[k][3]}
        o[d0] = __builtin_amdgcn_mfma_f32_32x32x16_bf16(pa0, PK(0), o[d0], 0, 0, 0);
        o[d0] = __builtin_amdgcn_mfma_f32_32x32x16_bf16(pa1, PK(1), o[d0], 0, 0, 0);
        o[d0] = __builtin_amdgcn_mfma_f32_32x32x16_bf16(pa2, PK(2), o[d0], 0, 0, 0);
        o[d0] = __builtin_amdgcn_mfma_f32_32x32x16_bf16(pa3, PK(3), o[d0], 0, 0, 0);
#undef PK
    }
}
__device__ __forceinline__ void attn_unit(const Frame& F, int b, int h, int jb) {
    LAS char* shm = (LAS char*)F.lds;
    const int lane = F.lane, r32 = lane & 31, hi = lane >> 5, wid = F.wave;
    const long rowbase = (long)b * T; const int q0 = jb * 256;
    const bf16* Qw = F.Z() + (rowbase + q0 + wid * 32) * DIN + Z_CQ + h * 64;
    const bf16* Kh = F.Z() + rowbase * DIN + Z_CK + h * 64; const bf16* Vh = F.Z() + rowbase * DIN + Z_CV + h * 64;
    const unsigned lds0 = (unsigned)(uintptr_t)shm;
    LAS float* wsf = (LAS float*)(shm + LDS_WS) + wid * 64;
    const bf16* ksrc = Kh + (long)lane * DIN + wid * 8;
    const bf16* vsrc = Vh + (long)(16 * (wid & 3) + (lane >> 2)) * DIN + (wid >> 2) * 32 + (lane & 3) * 8;
    const unsigned kdst = lds0 + LDS_K + wid * 1024, vdst = lds0 + LDS_V + wid * 1024;
#define DMA_K(pt, slot) glds16(ksrc + (long)(pt) * 64 * DIN, (unsigned)__builtin_amdgcn_readfirstlane(kdst + (slot)))
#define DMA_V(pt, slot) glds16(vsrc + (long)(pt) * 64 * DIN, (unsigned)__builtin_amdgcn_readfirstlane(vdst + (slot)))
    const int vb0 = (int)(lds0 + LDS_V) + ((lane >> 4) & 1) * 32 + (lane & 3) * 8 + (4 * hi + ((lane & 15) >> 2)) * 64;
    const lds_cptr kp0 = (lds_cptr)shm + LDS_K + hi * 1024 + r32 * 16;
    bf16x8 qr[4];
#pragma unroll
    for (int d0 = 0; d0 < 4; ++d0) qr[d0] = *(const bf16x8*)(Qw + (long)r32 * DIN + d0 * 16 + hi * 8);
    const int qrel = wid * 32 + r32;
    const unsigned selm = F.SEL()[(size_t)(rowbase + q0 + qrel) * 8 + h];
    unsigned wor = selm;
#pragma unroll
    for (int o_ = 1; o_ < 32; o_ <<= 1) wor |= (unsigned)__shfl_xor((int)wor, o_);
    LAS unsigned* flg = (LAS unsigned*)(shm + LDS_FLAG);
    __syncthreads();
    if (lane == 0) flg[wid] = wor;
    __syncthreads();
    unsigned rem = 0u;
#pragma unroll
    for (int w = 0; w < NWAVES; ++w) rem |= flg[w];
    rem = (unsigned)__builtin_amdgcn_readfirstlane((int)rem);
    const float beta = exp2f(-(float)(h + 1)) * LOG2E;
    float mhat = 0.f, l_reg = 0.f; f32x16 o[2];
#pragma unroll
    for (int r = 0; r < 16; ++r) { o[0][r] = 0.f; o[1][r] = 0.f; }
    int blk = jb, ti = 0, slot = 0; bool first = true;
    DMA_K(4 * blk, 0); DMA_V(4 * blk, 0);
    for (;;) {
        int nblk = blk, nti = ti + 1; bool has_next = true;
        if (nti == 4) { if (rem) { nblk = __builtin_ctz(rem); rem &= rem - 1u; nti = 0; } else has_next = false; }
        asm volatile("s_waitcnt vmcnt(0) lgkmcnt(0)\n\ts_barrier" ::: "memory");
        if (has_next) { DMA_K(4 * nblk + nti, (slot ^ 1) * SLOTB); DMA_V(4 * nblk + nti, (slot ^ 1) * SLOTB); }
        f32x16 negm;
#pragma unroll
        for (int r = 0; r < 16; ++r) negm[r] = -mhat;
        f32x16 p0, p1; qkt(p0, p1, kp0 + slot * SLOTB, qr, negm);
        const int pt = 4 * blk + ti;
        if (blk == jb) {
            const int kb = 64 * ti + 4 * hi;
#pragma unroll
            for (int r = 0; r < 16; ++r) { const int kv = kb + (r & 3) + 8 * (r >> 2); if (kv > qrel) p0[r] = -INFINITY; if (kv + 32 > qrel) p1[r] = -INFINITY; }
        } else if (!((selm >> blk) & 1u)) {
#pragma unroll
            for (int r = 0; r < 16; ++r) { p0[r] = -INFINITY; p1[r] = -INFINITY; }
        }
        const float ab = beta * (float)(64 * pt + 4 * hi - (q0 + qrel));
#pragma unroll
        for (int r = 0; r < 16; ++r) { const float cr = (float)((r & 3) + 8 * (r >> 2)); p0[r] += ab + beta * cr; p1[r] += ab + beta * (cr + 32.f); }
        const float rm = rowmax(p0, p1);
        bool resc = false;
        if (first || __any(rm > 0.f)) {
            const float dl = first ? rm : fmaxf(rm, 0.f); mhat += dl;
#pragma unroll
            for (int r = 0; r < 16; ++r) { p0[r] -= dl; p1[r] -= dl; }
            if (!first) { const float f = __builtin_amdgcn_exp2f(-dl); l_reg *= f; if (hi == 0) wsf[r32] = f; resc = true; }
        }
        if (resc) {
#pragma unroll
            for (int d_ = 0; d_ < 2; ++d_)
#pragma unroll
                for (int r = 0; r < 16; ++r) o[d_][r] *= wsf[crow(r, hi)];
        }
        float sacc = 0.f;
#pragma unroll
        for (int r = 0; r < 16; ++r) { p0[r] = __builtin_amdgcn_exp2f(p0[r]); p1[r] = __builtin_amdgcn_exp2f(p1[r]); sacc += p0[r] + p1[r]; }
        l_reg += sacc;
        v4u pw0, pw1, pw2, pw3;
#define PKW(P, B) cvtpk_s(P[B], P[B + 1])
        pw0 = (v4u){PKW(p0, 0), PKW(p0, 2), PKW(p0, 4), PKW(p0, 6)}; pw1 = (v4u){PKW(p0, 8), PKW(p0, 10), PKW(p0, 12), PKW(p0, 14)};
        pw2 = (v4u){PKW(p1, 0), PKW(p1, 2), PKW(p1, 4), PKW(p1, 6)}; pw3 = (v4u){PKW(p1, 8), PKW(p1, 10), PKW(p1, 12), PKW(p1, 14)};
#undef PKW
        __builtin_amdgcn_sched_barrier(0);
        pv(o, vb0 + slot * SLOTB, __builtin_bit_cast(bf16x8, pw0), __builtin_bit_cast(bf16x8, pw1), __builtin_bit_cast(bf16x8, pw2), __builtin_bit_cast(bf16x8, pw3));
        first = false;
        if (!has_next) break;
        blk = nblk; ti = nti; slot ^= 1;
    }
#undef DMA_K
#undef DMA_V
    { auto rr = __builtin_amdgcn_permlane32_swap(__float_as_uint(l_reg), __float_as_uint(l_reg), false, false); l_reg = __uint_as_float(rr[0]) + __uint_as_float(rr[1]); }
    if (hi == 0) wsf[32 + r32] = l_reg;
    float rli[16];
#pragma unroll
    for (int r = 0; r < 16; ++r) rli[r] = 1.f / wsf[32 + crow(r, hi)];
    LAS bf16* stg = (LAS bf16*)(shm + LDS_OST) + wid * 2048;
#pragma unroll
    for (int r = 0; r < 16; ++r) { const int orow = crow(r, hi);
#pragma unroll
        for (int d0 = 0; d0 < 2; ++d0) stg[orow * 64 + d0 * 32 + r32] = (bf16)f2bf(o[d0][r] * rli[r]); }
    bf16* Ow = F.Y() + (rowbase + q0 + wid * 32) * DM + Y_C + h * 64;
#pragma unroll
    for (int i = 0; i < 4; ++i) { const int row = i * 8 + (lane >> 3), ch = lane & 7; const v4u v = *(const LAS v4u*)(stg + row * 64 + ch * 8); *(v4u*)(Ow + (long)row * DM + ch * 8) = v; }
}
}

__device__ __forceinline__ void ycnorm_rows(const Frame& F) {
    const int gw = F.vcu * NWAVES + F.wave, NGW = F.G * NWAVES;
    for (int m = gw; m < M; m += NGW) { bf16* p = F.Y() + (size_t)m * DM + Y_C + F.lane * 8; float v[8]; unpack8(*(const v4u*)p, v); float s = 0.f;
#pragma unroll
        for (int j = 0; j < 8; ++j) s += v[j] * v[j];
        s = wave_sum(s); const float rs = rsqrtf(s * (1.f / 512.f) + EPS);
#pragma unroll
        for (int j = 0; j < 8; ++j) v[j] *= rs;
        *(v4u*)p = pack8(v); }
}
__device__ __forceinline__ void final_norm_rows(const Frame& F) {
    const int gw = F.vcu * NWAVES + F.wave, NGW = F.G * NWAVES;
    for (int m = gw; m < M; m += NGW) { GAS f32x4* xr = (GAS f32x4*)(F.out + (size_t)m * DM) + F.lane; const f32x4 s4 = *(const f32x4*)(F.SSQ() + (size_t)m * 4);
        const float rs = rsqrtf(((s4[0] + s4[1]) + (s4[2] + s4[3])) * (1.f / DM) + EPS);
#pragma unroll
        for (int j = 0; j < 4; ++j) { const f32x4 g = *((const f32x4*)F.norm_final() + F.lane + 64 * j); xr[64 * j] = xr[64 * j] * rs * g; } }
}

struct Args { const float* in[19]; float* out; unsigned char* ws; int ph_lo, ph_hi, use_bar, pad; };
__global__ void __launch_bounds__(NWAVES * 64, 2) mk_fwd(Args args) {
    __shared__ __attribute__((aligned(16))) unsigned char lds[LDS_BYTES];
    Frame F;
    F.lds = (LAS unsigned char*)lds;
    F.tid = threadIdx.x; F.lane = F.tid & 63; F.wave = __builtin_amdgcn_readfirstlane(F.tid >> 6);
    F.G = gridDim.x; { const int bx = blockIdx.x; F.vcu = (F.G % 8 == 0) ? (bx % 8) * (F.G / 8) + bx / 8 : bx; }
    const int vcu0 = F.vcu;
    F.ka = (const unsigned char*)__builtin_amdgcn_kernarg_segment_ptr(); F.ws = args.ws; F.out = args.out;
    unsigned char* ws = args.ws;
    for (int u = F.tid; u < (LDS_BYTES - LDSCTL_OFF) / 4; u += NWAVES * 64) ((LAS unsigned*)(F.lds + LDSCTL_OFF))[u] = 0u;
    __syncthreads();
    XcdBarrier bar; bar.bar = (unsigned*)(ws + WS_CTL) + CW_BAR; bar.x = 0; bar.st = nullptr;
    if (args.use_bar) bar = xcd_barrier_post((unsigned*)(ws + WS_CTL) + CW_BAR, (volatile LAS unsigned*)(F.lds + MISC_OFF) + 8);

    for (int ph = args.ph_lo; ph < args.ph_hi; ++ph) {
        {
            int t_ = threadIdx.x; asm volatile("" : "+v"(t_)); F.tid = t_; F.lane = t_ & 63; F.wave = __builtin_amdgcn_readfirstlane(t_ >> 6);
            int v_ = vcu0; asm volatile("" : "+s"(v_)); F.vcu = v_;
            unsigned char* w_ = args.ws; asm volatile("" : "+s"(w_)); F.ws = w_;
            float* o_ = args.out; asm volatile("" : "+s"(o_)); F.out = o_;
        }
        const int l = (ph - 1) >> 3, k = (ph == 0) ? -1 : (ph == NPH - 1 ? 8 : ((ph - 1) & 7));
        if (k == -1) {
            p0_prologue(F);
        } else if (k == 0) {
            pg8::Gemm g{F.XB(), F.WIN() + (size_t)l * DIN * DM, M, DIN, DM}; pg8::StaticOrder S; S.init(M, DIN, F.G, (int)blockIdx.x);
            pg8::EpiScale<0> E{F.Z(), DIN, F.SSQ(), 1.f / DM, EPS, Z_CQ, Z_CK, C2};
            pg8::gemm_phase<pg8::EpiScale<0>, pg8::StaticOrder, true, true>(F.lds, g, S, E);
        } else if (k == 1) {
            for (int it = F.vcu; it < 512 + 1024 + 64; it += F.G) {
                if (it < 1024) hg_unit(F, l, it, false);
                else if (it < 1536) lru_unit(F, l, it - 1024, false);
                else kmean_unit(F, it - 1536);
            }
        } else if (k == 2) {
            for (int it = F.vcu; it < 64 + 1 + 256; it += F.G) {
                if (it < 256) select_unit(F, it);
                else if (it < 320) hg_scan_item(F, it - 256);
                else lru_scan_item(F);
            }
        } else if (k == 3) {
            { const int bh = F.vcu >> 4, s = F.vcu & 15;
              if (bh < 16) { moba::attn_unit(F, bh >> 3, bh & 7, 31 - s); moba::attn_unit(F, bh >> 3, bh & 7, s); } }
            for (int it = F.vcu; it < 1024 + 512; it += F.G) {
                if (it < 1024) hg_unit(F, l, it, true); else lru_unit(F, l, it - 1024, true);
            }
        } else if (k == 4) {
            ycnorm_rows(F);
        } else if (k == 5) {
            pg8::Gemm g{F.Y(), F.WOUT() + (size_t)l * DM * DM, M, DM, DM}; pg8::StaticOrder S; S.init(M, DM, F.G, (int)blockIdx.x);
            pg8::EpiRes E{l == 0 ? F.x() : F.out, F.out, F.XB(), F.SSQ(), DM};
            pg8::gemm_phase<pg8::EpiRes, pg8::StaticOrder, false, true>(F.lds, g, S, E);
        } else if (k == 6) {
            pg8::Gemm g{F.XB(), F.W1() + (size_t)l * FF * DM, M, FF, DM}; pg8::StaticOrder S; S.init(M, FF, F.G, (int)blockIdx.x);
            pg8::EpiScale<1> E{F.H(), FF, F.SSQ(), 1.f / DM, EPS, 0, 0, 1.f};
            pg8::gemm_phase<pg8::EpiScale<1>, pg8::StaticOrder, true, true>(F.lds, g, S, E);
        } else if (k == 7) {
            pg8::Gemm g{F.H(), F.W2() + (size_t)l * DM * FF, M, DM, FF}; pg8::StaticOrder S; S.init(M, DM, F.G, (int)blockIdx.x);
            pg8::EpiRes E{F.out, F.out, F.XB(), F.SSQ(), DM};
            pg8::gemm_phase<pg8::EpiRes, pg8::StaticOrder, false, true>(F.lds, g, S, E);
        } else {
            final_norm_rows(F);
        }
        if (ph + 1 < args.ph_hi) xcd_barrier(bar);
    }
}


#ifndef DBG_STOP
#define DBG_STOP 0
#endif
#if DBG_STOP
__global__ void dbg_dump(float* out, const unsigned char* ws, int keep_out) {
    const size_t n = (size_t)M * DM;
    for (size_t i = (size_t)blockIdx.x * blockDim.x + threadIdx.x; i < n; i += (size_t)gridDim.x * blockDim.x) {
        float v = 0.f; if (keep_out) { float t = out[i]; v = (t == t && fabsf(t) < 1e30f) ? t : 1e21f; }
        const bf16* big = (const bf16*)(ws + WS_Z);
        for (int q = 0; q < 4; ++q) { float t = bf1(big[i + (size_t)q * n]); const int cc = (int)(i % 1024); const float sen = q < 3 ? 1e9f : (cc < 256 ? 1e12f : (cc < 512 ? 1e15f : 1e18f)); v += (t == t && fabsf(t) < 1e30f) ? t : sen; }
        const float* sm = (const float*)(ws + 1 * MiB); { const size_t si = i % (4 * MiB / 4); float t = (si >= 128 * 1024 && si < 256 * 1024) ? 0.f : sm[si]; v += (t == t && fabsf(t) < 1e30f) ? t : 1e12f; }
        const float* hs = (const float*)(ws + WS_HGS); { float t = hs[i % (16 * MiB / 4)]; v += (t == t && fabsf(t) < 1e30f) ? t : 1e15f; }
        const bf16* xb = (const bf16*)(ws + WS_XB); { float t = bf1(xb[i]); v += (t == t && fabsf(t) < 1e30f) ? t : 1e18f; }
        out[i] = v;
    }
}
#endif
extern "C" void kernel_launch(void* const* d_in, const int* in_sizes, int n_in, void* d_out, int out_size, void* d_ws, size_t ws_size, hipStream_t stream) {
    if (n_in != 19 || out_size != M * DM || ws_size < WS_END) { fprintf(stderr, "kernel_launch: unexpected shapes (n_in %d, out %d, ws %zu)\n", n_in, out_size, ws_size); return; }
    const int grid = 256;
    (void)hipMemsetAsync((char*)d_ws + WS_CTL, 0, CTL_ZERO_BYTES, stream);
    Args a{};
    for (int i = 0; i < 19; ++i) a.in[i] = (const float*)d_in[i];
    a.out = (float*)d_out; a.ws = (unsigned char*)d_ws;
#if MK_ONE_LAUNCH
    a.ph_lo = 0; a.ph_hi = NPH; a.use_bar = 1;
    hipLaunchKernelGGL(mk_fwd, dim3(grid), dim3(NWAVES * 64), 0, stream, a);
#else
#if DBG_STOP
    const int nph = DBG_STOP;
#else
    const int nph = NPH;
#endif
    for (int ph = 0; ph < nph; ++ph) { a.ph_lo = ph; a.ph_hi = ph + 1; a.use_bar = 0; hipLaunchKernelGGL(mk_fwd, dim3(grid), dim3(NWAVES * 64), 0, stream, a); }
#if DBG_STOP
    hipLaunchKernelGGL(dbg_dump, dim3(2048), dim3(256), 0, stream, (float*)d_out, (const unsigned char*)d_ws, (int)(DBG_STOP >= 7));
#endif
#endif
}
```

```cpp
#include <hip/hip_runtime.h>
#include <hip/hip_bf16.h>
#include <cstdio>
#include <cstdint>
#include <cmath>
namespace pg8 {
#define PG8_LAS __attribute__((address_space(3)))
typedef unsigned short bf16_t;
typedef short bf16x8 __attribute__((ext_vector_type(8)));
typedef float f32x4 __attribute__((ext_vector_type(4)));
typedef unsigned u32x4 __attribute__((ext_vector_type(4)));
constexpr int BM = 256, BK = 64, HALF = 128, HTB = HALF * BK * 2  , STAGE_BYTES = 8 * HTB, NXCD = 8, WGM = 8;

__host__ __device__ __forceinline__ int lds_byte(int r, int c) { const int st = (r >> 4) * 2 + (c >> 5), rr = r & 15, cc = c & 31, ob = rr * 64 + cc * 2; return st * 1024 + (ob ^ (((ob >> 9) & 1) << 5)); }
__host__ __device__ __forceinline__ void stage_rc(int b, int& R, int& C) { const int st = b / 1024, sb = b % 1024, swz = sb ^ (((sb >> 9) & 1) << 5); R = (st >> 1) * 16 + swz / 64; C = (st & 1) * 32 + (swz % 64) / 2; }
__host__ __device__ __forceinline__ int perm32(int rho) { const int n = rho >> 4, i = rho & 15; return 8 * (i >> 2) + 4 * n + (i & 3); }

struct Unit { int pm, pn; };
struct Gemm { const bf16_t* A; const bf16_t* Bt; int M, N, K; };

struct StaticOrder {
    int nM, nN, nwg, G, c;
    __host__ __device__ void init(int M, int N, int G_, int c_) { nM = M / BM; nN = N / BM; nwg = nM * nN; G = G_; c = c_; }
    __host__ __device__ bool next(int i, Unit& u) const {
        const long L = (long)i * G + c; if (L >= nwg) return false;
        int wgid = (int)L; { const int q = nwg / NXCD, r = nwg % NXCD, xcd = wgid % NXCD, off = wgid / NXCD; wgid = (xcd < r ? xcd * (q + 1) : r * (q + 1) + (xcd - r) * q) + off; }
        const int nig = WGM * nN, gid = wgid / nig, fm = gid * WGM, gsz = (nM - fm) < WGM ? (nM - fm) : WGM;
        u.pm = fm + ((wgid % nig) % gsz); u.pn = (wgid % nig) / gsz; return true;
    }
    __device__ __forceinline__ void a_ready(const Unit&) const {}
    __device__ __forceinline__ void done(const Unit&) const {}
};
__device__ __forceinline__ unsigned cvt_pk_bf16(float lo, float hi) { unsigned r; asm volatile("v_cvt_pk_bf16_f32 %0, %1, %2" : "=v"(r) : "v"(lo), "v"(hi)); return r; }
typedef float f32x2 __attribute__((ext_vector_type(2)));
typedef unsigned u32x2 __attribute__((ext_vector_type(2)));
template <int ACT> struct EpiScale {
    static constexpr bool PERM = true, AFTER_DRAIN = false;
    bf16_t* O; int ldc; const float* ssq; float inv_k, eps; int sc_lo, sc_hi; float sc;
    __device__ __forceinline__ void operator()(const f32x4 (&acc)[2][2][4][2], const Unit& u, int wr, int wc, int fr, int fq) const {
        const int row0 = u.pm * BM + wr * 64 + fr; const int colt = u.pn * BM;
        const float cs = (colt >= sc_lo && colt < sc_hi) ? sc : 1.f;
        const int col0 = colt + wc * 32 + 8 * fq;
#pragma unroll
        for (int ai = 0; ai < 2; ++ai)
#pragma unroll
            for (int m = 0; m < 4; ++m) { const int row = row0 + ai * HALF + m * 16;
                const f32x4 s4 = *(const f32x4*)(ssq + (size_t)row * 4);
                const float rs = rsqrtf(((s4[0] + s4[1]) + (s4[2] + s4[3])) * inv_k + eps) * cs;
                bf16_t* rowp = O + (size_t)row * ldc + col0;
#pragma unroll
                for (int bj = 0; bj < 2; ++bj) { f32x4 v0 = acc[ai][bj][m][0] * rs, v1 = acc[ai][bj][m][1] * rs;
                    if (ACT == 1) {
#pragma unroll
                        for (int e = 0; e < 4; ++e) { const float a0 = fmaxf(v0[e], 0.f), a1 = fmaxf(v1[e], 0.f); v0[e] = a0 * a0; v1[e] = a1 * a1; } }
                    u32x4 w; w.x = cvt_pk_bf16(v0[0], v0[1]); w.y = cvt_pk_bf16(v0[2], v0[3]); w.z = cvt_pk_bf16(v1[0], v1[1]); w.w = cvt_pk_bf16(v1[2], v1[3]);
                    *(u32x4*)(rowp + bj * HALF) = w; } }
    }
};
struct EpiRes {
    static constexpr bool PERM = false, AFTER_DRAIN = true;
    const float* base; float* out; bf16_t* xb; float* ssq; int ldc;
    __device__ __forceinline__ void fused(f32x4 (&acc)[2][2][4][2], const Unit& u, int wr, int wc, int fr, int fq, PG8_LAS unsigned char* lds, int wid, int lane) const {
        PG8_LAS float* P = (PG8_LAS float*)lds;
#if defined(DBG_ZACC)
#pragma unroll
        for (int a_ = 0; a_ < 2; ++a_)
#pragma unroll
            for (int b_ = 0; b_ < 2; ++b_)
#pragma unroll
                for (int m_ = 0; m_ < 4; ++m_)
#pragma unroll
                    for (int n_ = 0; n_ < 2; ++n_) acc[a_][b_][m_][n_] = (f32x4){0.f, 0.f, 0.f, 0.f};
#endif
        const int col0 = u.pn * BM + wc * 32 + 4 * fq;
#pragma unroll
        for (int ai = 0; ai < 2; ++ai)
#pragma unroll
            for (int m = 0; m < 4; ++m) { const int r = ai * HALF + wr * 64 + m * 16 + fr; const size_t off = (size_t)(u.pm * BM + r) * ldc + col0; float ps = 0.f;
#pragma unroll
                for (int bj = 0; bj < 2; ++bj)
#pragma unroll
                    for (int n = 0; n < 2; ++n) { const f32x4 bs = *(const f32x4*)(base + off + bj * HALF + n * 16); const f32x4 o = bs + acc[ai][bj][m][n];
                        *(f32x4*)(out + off + bj * HALF + n * 16) = o; ps += (o[0] * o[0] + o[1] * o[1]) + (o[2] * o[2] + o[3] * o[3]);
                        u32x2 w; w.x = cvt_pk_bf16(o[0], o[1]); w.y = cvt_pk_bf16(o[2], o[3]); *(u32x2*)(xb + off + bj * HALF + n * 16) = w; }
                ps += __shfl_xor(ps, 16); ps += __shfl_xor(ps, 32);
                if (fq == 0) P[r * 4 + wc] = ps;
                if (m & 1) asm volatile("" ::: "memory"); }
        __syncthreads();
        const int t = wid * 64 + lane;
        if (t < 256) ssq[(size_t)(u.pm * BM + t) * 4 + u.pn] = (P[t * 4] + P[t * 4 + 1]) + (P[t * 4 + 2] + P[t * 4 + 3]);
    }
};
template <class Epi, class Sched, bool ALIGN_EPI = false, bool SP2 = false>
__device__ __forceinline__ void gemm_phase(PG8_LAS unsigned char* lds, const Gemm g, const Sched& S, const Epi& E) {
    int tid_l = threadIdx.x; asm volatile("" : "+v"(tid_l));
    const int tid = tid_l, wid = __builtin_amdgcn_readfirstlane(tid >> 6), lane = tid & 63, wr = wid >> 2, wc = wid & 3, fr = lane & 15, fq = lane >> 4;
    const int K = g.K, nt = K / BK;
    unsigned voffA[2], voffB[2];
#pragma unroll
    for (int i = 0; i < 2; ++i) { int R, C; stage_rc(tid * 16 + i * 8192, R, C); const int Rb = Epi::PERM ? ((R & ~31) + perm32(R & 31)) : R;
        voffA[i] = (unsigned)(R * K + C) * 2u; voffB[i] = (unsigned)(Rb * K + C) * 2u; }
    const size_t kstep = (size_t)(BK * 2);
    const size_t hstep = (size_t)HALF * K * 2;
    const size_t tstep = 2 * hstep;
    const unsigned ldsw = (unsigned)wid * 1024u;
    const int aoff = lds_byte(wr * 64 + fr, fq * 8), boff = lds_byte(wc * 32 + fr, fq * 8);
#define PG8_SA(b, h) (((b) * 2 + (h)) * HTB)
#define PG8_SB(b, h) ((4 + (b) * 2 + (h)) * HTB)
#define PG8_STAGE(bufoff, gbase, voff) do { _Pragma("unroll") for (int _i = 0; _i < 2; ++_i) \
        __builtin_amdgcn_global_load_lds((const unsigned*)((const char*)(gbase) + (voff)[_i]), (PG8_LAS unsigned*)(lds + (bufoff) + ldsw + _i * 8192), 16, 0, 0); } while (0)
#define PG8_LDA(dst, b, h) do { _Pragma("unroll") for (int m = 0; m < 4; ++m) _Pragma("unroll") for (int k = 0; k < 2; ++k) dst[m][k] = *(const PG8_LAS bf16x8*)(lds + PG8_SA(b, h) + aoff + m * 2048 + k * 1024); } while (0)
#define PG8_LDB(dst, b, h) do { _Pragma("unroll") for (int n = 0; n < 2; ++n) _Pragma("unroll") for (int k = 0; k < 2; ++k) dst[n][k] = *(const PG8_LAS bf16x8*)(lds + PG8_SB(b, h) + boff + n * 2048 + k * 1024); } while (0)
#define PG8_MMA(ai, bj, At, Bt) do { __builtin_amdgcn_s_setprio(1); _Pragma("unroll") for (int m = 0; m < 4; ++m) _Pragma("unroll") for (int n = 0; n < 2; ++n) _Pragma("unroll") for (int k = 0; k < 2; ++k) \
        acc[ai][bj][m][n] = __builtin_amdgcn_mfma_f32_16x16x32_bf16(Bt[n][k], At[m][k], acc[ai][bj][m][n], 0, 0, 0); __builtin_amdgcn_s_setprio(0); } while (0)
#define PG8_WAIT_V(n) asm volatile("s_waitcnt vmcnt(" #n ")" ::: "memory")
#define PG8_WAIT_L(n) asm volatile("s_waitcnt lgkmcnt(" #n ")" ::: "memory")
#define PG8_BAR __builtin_amdgcn_s_barrier()
#define PG8_SCHED __builtin_amdgcn_sched_barrier(0)
    Unit cur, nxt; int ui = 0;
    if (!S.next(0, cur)) return;
    f32x4 acc[2][2][4][2];
#pragma unroll
    for (int a = 0; a < 2; ++a)
#pragma unroll
        for (int b = 0; b < 2; ++b)
#pragma unroll
            for (int m = 0; m < 4; ++m)
#pragma unroll
                for (int n = 0; n < 2; ++n) acc[a][b][m][n] = (f32x4){0.f, 0.f, 0.f, 0.f};
    bf16x8 At[4][2], B0[2][2], B1[2][2];
    const char* cA = (const char*)g.A + (size_t)cur.pm * tstep; const char* cB = (const char*)g.Bt + (size_t)cur.pn * tstep;
    S.a_ready(cur);
    if constexpr (SP2) {
        PG8_STAGE(PG8_SB(0, 0), cB, voffB); PG8_STAGE(PG8_SB(0, 1), cB + hstep, voffB); PG8_STAGE(PG8_SA(0, 0), cA, voffA); PG8_STAGE(PG8_SA(0, 1), cA + hstep, voffA);
        if (wr == 1) PG8_BAR;
        PG8_WAIT_V(2); PG8_BAR;
        PG8_STAGE(PG8_SB(1, 0), cB + kstep, voffB); PG8_STAGE(PG8_SA(1, 0), cA + kstep, voffA); PG8_STAGE(PG8_SB(1, 1), cB + hstep + kstep, voffB);
        PG8_WAIT_V(6); PG8_BAR;
    } else {
        PG8_STAGE(PG8_SB(0, 0), cB, voffB); PG8_STAGE(PG8_SA(0, 0), cA, voffA); PG8_STAGE(PG8_SB(0, 1), cB + hstep, voffB); PG8_STAGE(PG8_SA(0, 1), cA + hstep, voffA);
        if (wr == 1) PG8_BAR;
        PG8_WAIT_V(4); PG8_BAR;
        PG8_STAGE(PG8_SB(1, 0), cB + kstep, voffB); PG8_STAGE(PG8_SA(1, 0), cA + kstep, voffA); PG8_STAGE(PG8_SB(1, 1), cB + hstep + kstep, voffB);
        PG8_WAIT_V(6); PG8_BAR;
    }
    for (;;) {
        const bool has_next = S.next(ui + 1, nxt);
        const char* nA = has_next ? (const char*)g.A + (size_t)nxt.pm * tstep : cA; const char* nB = has_next ? (const char*)g.Bt + (size_t)nxt.pn * tstep : cB;
        for (int t = 0; t < nt; t += 2) {
            const bool last = (t == nt - 2);
            const char* a1 = cA + (size_t)(t + 1) * kstep;
            const char* a2 = last ? nA : cA + (size_t)(t + 2) * kstep; const char* b2 = last ? nB : cB + (size_t)(t + 2) * kstep;
            const char* a3 = a2 + kstep; const char* b3 = b2 + kstep;
            if (last && has_next) S.a_ready(nxt);
            if constexpr (SP2) {
            PG8_LDB(B0, 0, 0); PG8_LDB(B1, 0, 1); PG8_SCHED; PG8_LDA(At, 0, 0); PG8_STAGE(PG8_SA(1, 1), a1 + hstep, voffA);
            PG8_WAIT_V(8); PG8_WAIT_L(0); PG8_BAR; PG8_MMA(0, 0, At, B0); PG8_MMA(0, 1, At, B1); PG8_BAR; PG8_SCHED;
            PG8_LDA(At, 0, 1); PG8_STAGE(PG8_SB(0, 0), b2, voffB); PG8_STAGE(PG8_SB(0, 1), b2 + hstep, voffB); PG8_STAGE(PG8_SA(0, 0), a2, voffA);
            PG8_WAIT_V(8); PG8_WAIT_L(0); PG8_BAR; PG8_MMA(1, 0, At, B0); PG8_MMA(1, 1, At, B1); PG8_BAR; PG8_SCHED;
            PG8_LDB(B0, 1, 0); PG8_LDB(B1, 1, 1); PG8_SCHED; PG8_LDA(At, 1, 0); PG8_STAGE(PG8_SA(0, 1), a2 + hstep, voffA);
            PG8_WAIT_V(8); PG8_WAIT_L(0); PG8_BAR; PG8_MMA(0, 0, At, B0); PG8_MMA(0, 1, At, B1); PG8_BAR; PG8_SCHED;
            PG8_LDA(At, 1, 1); PG8_STAGE(PG8_SB(1, 0), b3, voffB); PG8_STAGE(PG8_SB(1, 1), b3 + hstep, voffB); PG8_STAGE(PG8_SA(1, 0), a3, voffA);
            PG8_WAIT_V(8); PG8_WAIT_L(0); PG8_BAR; PG8_MMA(1, 0, At, B0); PG8_MMA(1, 1, At, B1); PG8_BAR; PG8_SCHED;
            } else {
            PG8_LDB(B0, 0, 0); PG8_SCHED; PG8_LDA(At, 0, 0); PG8_STAGE(PG8_SA(1, 1), a1 + hstep, voffA);
            PG8_WAIT_L(8); PG8_BAR; PG8_WAIT_L(0); PG8_MMA(0, 0, At, B0); PG8_BAR; PG8_SCHED;
            PG8_LDB(B1, 0, 1); PG8_STAGE(PG8_SB(0, 0), b2, voffB);
            PG8_BAR; PG8_WAIT_L(0); PG8_MMA(0, 1, At, B1); PG8_BAR;
            PG8_LDA(At, 0, 1); PG8_STAGE(PG8_SA(0, 0), a2, voffA);
            PG8_BAR; PG8_WAIT_L(0); PG8_MMA(1, 0, At, B0); PG8_BAR; PG8_SCHED;
            PG8_STAGE(PG8_SB(0, 1), b2 + hstep, voffB);
            PG8_WAIT_V(6); PG8_BAR; PG8_MMA(1, 1, At, B1); PG8_BAR;
            PG8_LDB(B0, 1, 0); PG8_SCHED; PG8_LDA(At, 1, 0); PG8_STAGE(PG8_SA(0, 1), a2 + hstep, voffA);
            PG8_WAIT_L(8); PG8_BAR; PG8_WAIT_L(0); PG8_MMA(0, 0, At, B0); PG8_BAR; PG8_SCHED;
            PG8_LDB(B1, 1, 1); PG8_STAGE(PG8_SB(1, 0), b3, voffB);
            PG8_BAR; PG8_WAIT_L(0); PG8_MMA(0, 1, At, B1); PG8_BAR;
            PG8_LDA(At, 1, 1); PG8_STAGE(PG8_SA(1, 0), a3, voffA);
            PG8_BAR; PG8_WAIT_L(0); PG8_MMA(1, 0, At, B0); PG8_BAR; PG8_SCHED;
            PG8_STAGE(PG8_SB(1, 1), b3 + hstep, voffB);
            PG8_WAIT_V(6); PG8_BAR; PG8_MMA(1, 1, At, B1); PG8_BAR;
            }
        }
        if constexpr (ALIGN_EPI) { if (wr == 0) PG8_BAR; }
        if constexpr (!Epi::AFTER_DRAIN) { E(acc, cur, wr, wc, fr, fq); S.done(cur); }
        if (!has_next) break;
#pragma unroll
        for (int a = 0; a < 2; ++a)
#pragma unroll
            for (int b = 0; b < 2; ++b)
#pragma unroll
                for (int m = 0; m < 4; ++m)
#pragma unroll
                    for (int n = 0; n < 2; ++n) acc[a][b][m][n] = (f32x4){0.f, 0.f, 0.f, 0.f};
        cur = nxt; cA = nA; cB = nB; ++ui;
        if constexpr (ALIGN_EPI) { if (wr == 1) PG8_BAR; }
    }
    PG8_WAIT_V(0);
    if constexpr (!ALIGN_EPI) { if (wr == 0) PG8_BAR; }
    PG8_BAR;
    if constexpr (Epi::AFTER_DRAIN) { E.fused(acc, cur, wr, wc, fr, fq, lds, wid, lane); S.done(cur); }
#undef PG8_SA
#undef PG8_SB
#undef PG8_STAGE
#undef PG8_LDA
#undef PG8_LDB
#undef PG8_MMA
#undef PG8_WAIT_V
#undef PG8_WAIT_L
#undef PG8_BAR
#undef PG8_SCHED
}
}

constexpr int NWAVES = 8;
constexpr int BATCH = 2, T = 8192, DM = 1024, M = BATCH * T, DIN = 3072, FF = 4096, DEPTH = 2;
constexpr int Z_AX = 0, Z_AY = 256, Z_BQ = 512, Z_BF = 768, Z_BI = 1024, Z_BG = 1280, Z_CQ = 1536, Z_CK = 2048, Z_CV = 2560;
constexpr int Y_A = 0, Y_B = 256, Y_C = 512;
constexpr float EPS = 1e-6f;
constexpr float LOG2E = 1.4426950408889634f;
constexpr float C2 = 0.125f * LOG2E;
constexpr int NPH = 18;
#ifndef MK_ONE_LAUNCH
#define MK_ONE_LAUNCH 1
#endif

constexpr size_t MiB = 1u << 20, KiB = 1024;
constexpr size_t WS_CTL = 0, CTL_ZERO_BYTES = 64 * KiB;
constexpr size_t WS_SSQ = 1 * MiB;
constexpr size_t WS_KMP = 5 * MiB;
constexpr size_t WS_SEL = 1 * MiB + 512 * KiB;
constexpr size_t WS_LRUA = 2 * MiB;
constexpr size_t WS_LRUU = 2 * MiB + 512 * KiB;
constexpr size_t WS_LRUC = 3 * MiB;
constexpr size_t WS_HGD = 3 * MiB + 512 * KiB;
constexpr size_t WS_GW = 4 * MiB;
constexpr size_t WS_LB = 4 * MiB + 256 * KiB;
constexpr size_t WS_SP = 4 * MiB + 260 * KiB;
constexpr size_t WS_WIN = 8 * MiB;
constexpr size_t WS_WOUT = 20 * MiB;
constexpr size_t WS_W1 = 24 * MiB;
constexpr size_t WS_W2 = 40 * MiB;
constexpr size_t WS_XB = 56 * MiB;
constexpr size_t WS_HGS = 88 * MiB;
constexpr size_t WS_Z = 104 * MiB;
constexpr size_t WS_Y = 200 * MiB;
constexpr size_t WS_H = 104 * MiB;
constexpr size_t WS_END = 232 * MiB;
constexpr int CW_BAR = 1024;

constexpr int RING_BYTES = 131072, LDSCTL_OFF = RING_BYTES, MISC_OFF = LDSCTL_OFF + 320, LDS_BYTES = 147456;

#define GAS __attribute__((address_space(1)))
#define LAS __attribute__((address_space(3)))
typedef unsigned short bf16;
typedef unsigned v4u __attribute__((ext_vector_type(4)));
typedef float f32x4 __attribute__((ext_vector_type(4)));
typedef short bf16x8 __attribute__((ext_vector_type(8)));
typedef float f32x16 __attribute__((ext_vector_type(16)));
typedef short s16x4 __attribute__((ext_vector_type(4)));
#define RLX_AGENT __ATOMIC_RELAXED, __HIP_MEMORY_SCOPE_AGENT
__device__ __forceinline__ unsigned f2bf(float f) { unsigned u = __builtin_bit_cast(unsigned, f); return (u + 0x7fffu + ((u >> 16) & 1u)) >> 16; }
__device__ __forceinline__ unsigned pk2(float lo, float hi) { return f2bf(lo) | (f2bf(hi) << 16); }
__device__ __forceinline__ float bflo(unsigned u) { return __uint_as_float(u << 16); }
__device__ __forceinline__ float bfhi(unsigned u) { return __uint_as_float(u & 0xffff0000u); }
__device__ __forceinline__ float bf1(bf16 v) { return __uint_as_float((unsigned)v << 16); }
__device__ __forceinline__ void unpack8(const v4u v, float (&f)[8]) { f[0] = bflo(v.x); f[1] = bfhi(v.x); f[2] = bflo(v.y); f[3] = bfhi(v.y); f[4] = bflo(v.z); f[5] = bfhi(v.z); f[6] = bflo(v.w); f[7] = bfhi(v.w); }
__device__ __forceinline__ v4u pack8(const float (&f)[8]) { v4u v; v.x = pk2(f[0], f[1]); v.y = pk2(f[2], f[3]); v.z = pk2(f[4], f[5]); v.w = pk2(f[6], f[7]); return v; }
__device__ __forceinline__ float sigmoidf_(float x) { return 1.f / (1.f + __expf(-x)); }
__device__ __forceinline__ float wave_sum(float v) {
#pragma unroll
    for (int o = 1; o < 64; o <<= 1) v += __shfl_xor(v, o);
    return v;
}
#define XB_TMO      128
#define XB_XCNT(j)  (256  + 64 * (j))
#define XB_XSUB(j)  (1280 + 64 * (j))
#define XB_XGEN(j)  (2304 + 64 * (j))
#define XB_TOP      3328
#define XB_TOPGEN   3392
#define XCD_BAR_WORDS 3456
#define XB_SPIN_CAP (1u << 18)

__device__ __forceinline__ unsigned xb_ld(unsigned* p)              { return __hip_atomic_load(p, __ATOMIC_RELAXED, __HIP_MEMORY_SCOPE_AGENT); }
__device__ __forceinline__ unsigned xb_add(unsigned* p, unsigned v) { return __hip_atomic_fetch_add(p, v, __ATOMIC_RELAXED, __HIP_MEMORY_SCOPE_AGENT); }
__device__ __forceinline__ unsigned xb_xcc_id() { return (unsigned)__builtin_amdgcn_s_getreg((3 << 11) | 20) & 0xFu; }
#define XB_SPIN(cond, bar) do { unsigned _sp = 0; while (cond) { __builtin_amdgcn_s_sleep(1); \
    if ((++_sp & 255u) == 0u) { if (xb_ld(&(bar)[XB_TMO])) break; if (_sp > XB_SPIN_CAP) { atomicAdd(&(bar)[XB_TMO], 1u); break; } } } } while (0)

struct XcdBarrier {
    unsigned* bar; unsigned x;
    volatile LAS unsigned* st;
};

__device__ __forceinline__ XcdBarrier xcd_barrier_post(unsigned* bar, volatile LAS unsigned* st) {
    XcdBarrier b; b.bar = bar; b.x = xb_xcc_id(); b.st = st;
    if (threadIdx.x == 0) (void)xb_add(&bar[XB_XCNT(b.x)], 1u);
    return b;
}
__device__ __forceinline__ void xcd_barrier_complete(unsigned* bar, unsigned x, unsigned& nloc, unsigned& nx) {
    const unsigned G = gridDim.x * gridDim.y * gridDim.z;
    unsigned sum, cnt, mine, sp = 0u;
    for (;;) {
        sum = 0u; cnt = 0u; mine = 0u;
#pragma unroll
        for (unsigned j = 0; j < 16; ++j) { const unsigned c = xb_ld(&bar[XB_XCNT(j)]); sum += c; cnt += (c > 0u) ? 1u : 0u; mine = (j == x) ? c : mine; }
        if (sum == G) break;
        __builtin_amdgcn_s_sleep(1);
        if ((++sp & 255u) == 0u) { if (xb_ld(&bar[XB_TMO])) break; if (sp > XB_SPIN_CAP) { atomicAdd(&bar[XB_TMO], 1u); break; } }
    }
    nloc = mine > 0u ? mine : 1u; nx = cnt > 0u ? cnt : 1u;
}

__device__ __forceinline__ void xcd_barrier(const XcdBarrier& b) {
    asm volatile("s_waitcnt vmcnt(0)" ::: "memory");
    __syncthreads();
    if (threadIdx.x == 0) {
        unsigned* bar = b.bar;
        __builtin_amdgcn_s_waitcnt(0);
        unsigned nloc = b.st[0], nx = b.st[1];
        if (nloc == 0u) { xcd_barrier_complete(bar, b.x, nloc, nx); b.st[0] = nloc; b.st[1] = nx; }
        const unsigned old = xb_add(&bar[XB_XSUB(b.x)], 1u);
        const unsigned gen = old / nloc;
        if (old + 1u == (gen + 1u) * nloc) {
            __builtin_amdgcn_fence(__ATOMIC_RELEASE, "agent");
            asm volatile("s_waitcnt vmcnt(0)" ::: "memory");
            const unsigned og = xb_add(&bar[XB_TOP], 1u);
            const unsigned tg = og / nx;
            if (og + 1u == (tg + 1u) * nx) xb_add(&bar[XB_TOPGEN], 1u);
            else XB_SPIN(xb_ld(&bar[XB_TOPGEN]) == tg, bar);
            __builtin_amdgcn_fence(__ATOMIC_ACQUIRE, "agent");
            xb_add(&bar[XB_XGEN(b.x)], 1u);
            asm volatile("s_waitcnt vmcnt(0)" ::: "memory");
        } else {
            XB_SPIN(xb_ld(&bar[XB_XGEN(b.x)]) == gen, bar);
            __builtin_amdgcn_fence(__ATOMIC_ACQUIRE, "agent");
            asm volatile("s_waitcnt vmcnt(0)" ::: "memory");
        }
    }
    __syncthreads();
}

struct Frame {
    LAS unsigned char* lds;
    int tid, lane, wave, vcu, G;
    const unsigned char* ka;
    unsigned char* ws; float* out;
    __device__ __forceinline__ const float* in(int i) const { const unsigned char* k = ka; asm volatile("" : "+s"(k)); return *(const float* const*)(k + 8 * i); }
#define FIN(name, idx) __device__ __forceinline__ const float* name() const { return in(idx); }
    FIN(x, 0) FIN(w_in, 1) FIN(w_out, 2) FIN(norm_mix, 3) FIN(norm_mlp, 4) FIN(conv_w, 5) FIN(conv_b, 6) FIN(lru_wa, 7) FIN(lru_ba, 8) FIN(lru_wx, 9) FIN(lru_bx, 10) FIN(lru_lam, 11)
    FIN(hg_lb, 12) FIN(hg_nw, 13) FIN(lru_on, 14) FIN(att_on, 15) FIN(w_ff1, 16) FIN(w_ff2, 17) FIN(norm_final, 18)
#undef FIN
#define FWS(type, name, off) __device__ __forceinline__ type* name() const { return (type*)(ws + (off)); }
    FWS(float, SSQ, WS_SSQ) FWS(float, KMP, WS_KMP) FWS(unsigned, SEL, WS_SEL) FWS(float, LRUA, WS_LRUA) FWS(float, LRUU, WS_LRUU) FWS(float, LRUC, WS_LRUC) FWS(float, HGD, WS_HGD) FWS(float, HGS, WS_HGS)
    FWS(float, LB, WS_LB) FWS(float, SP, WS_SP) FWS(bf16, GW, WS_GW) FWS(bf16, WIN, WS_WIN) FWS(bf16, WOUT, WS_WOUT) FWS(bf16, W1, WS_W1) FWS(bf16, W2, WS_W2) FWS(bf16, XB, WS_XB) FWS(bf16, Z, WS_Z) FWS(bf16, Y, WS_Y) FWS(bf16, H, WS_H)
#undef FWS
};

__device__ __forceinline__ float gain_of(const float* g0, const float* g1, int mode, int k) {
    if (mode == 1 || mode == 2) return g0[k];
    if (mode == 3) return k < 256 ? g0[k] : (k < 512 ? 1.f : g1[k - 512]);
    return 1.f;
}
__device__ __forceinline__ void p0_transpose_item(const Frame& F, const float* W, int K, int N, bf16* WT, LAS float* scr, int item, int lane, int mode, int l) {
    const float* g0 = mode == 1 ? F.norm_mix() + l * DM : (mode == 2 ? F.norm_mlp() + l * DM : F.lru_on() + l * 256); const float* g1 = F.att_on() + l * 512;
    const int nblk = N / 32, kb = item / nblk, nb = item % nblk, k0 = 64 * kb, n0 = 32 * nb;
#pragma unroll 8
    for (int i = 0; i < 32; ++i) { const int kk = 2 * i + (lane >> 5); scr[kk * 33 + (lane & 31)] = W[(size_t)(k0 + kk) * N + n0 + (lane & 31)] * gain_of(g0, g1, mode, k0 + kk); }
    asm volatile("s_waitcnt lgkmcnt(0)" ::: "memory");
    const int c = lane & 7;
#pragma unroll
    for (int j = 0; j < 4; ++j) { const int n = (lane >> 3) + 8 * j; const LAS float* s = scr + (8 * c) * 33 + n;
        v4u o; o.x = pk2(s[0 * 33], s[1 * 33]); o.y = pk2(s[2 * 33], s[3 * 33]); o.z = pk2(s[4 * 33], s[5 * 33]); o.w = pk2(s[6 * 33], s[7 * 33]);
        *(GAS v4u*)(WT + (size_t)(n0 + n) * K + k0 + 8 * c) = o; }
    asm volatile("s_waitcnt lgkmcnt(0)" ::: "memory");
}
__device__ __forceinline__ void p0_prologue(const Frame& F) {
    LAS float* scr = (LAS float*)(F.lds + F.wave * 16384);
    const int gw = F.vcu * NWAVES + F.wave, NGW = F.G * NWAVES;
    constexpr int I_IN = (DM / 64) * (DIN / 32), I_OUT = (DM / 64) * (DM / 32), I_1 = (DM / 64) * (FF / 32), I_2 = (FF / 64) * (DM / 32);
    constexpr int PER_L = I_IN + I_OUT + I_1 + I_2;
    for (int it = gw; it < DEPTH * PER_L; it += NGW) {
        const int l = it / PER_L; int r = it % PER_L;
        if (r < I_IN) { p0_transpose_item(F, F.w_in() + (size_t)l * DM * DIN, DM, DIN, F.WIN() + (size_t)l * DIN * DM, scr, r, F.lane, 1, l); continue; } r -= I_IN;
        if (r < I_OUT) { p0_transpose_item(F, F.w_out() + (size_t)l * DM * DM, DM, DM, F.WOUT() + (size_t)l * DM * DM, scr, r, F.lane, 3, l); continue; } r -= I_OUT;
        if (r < I_1) { p0_transpose_item(F, F.w_ff1() + (size_t)l * DM * FF, DM, FF, F.W1() + (size_t)l * FF * DM, scr, r, F.lane, 2, l); continue; } r -= I_1;
        p0_transpose_item(F, F.w_ff2() + (size_t)l * FF * DM, FF, DM, F.W2() + (size_t)l * DM * FF, scr, r, F.lane, 0, l);
    }
    for (int m = gw; m < M; m += NGW) {
        const GAS f32x4* xr = (const GAS f32x4*)(F.x() + (size_t)m * DM) + F.lane; f32x4 v[4]; float s = 0.f;
#pragma unroll
        for (int j = 0; j < 4; ++j) { v[j] = xr[64 * j]; s += (v[j].x * v[j].x + v[j].y * v[j].y) + (v[j].z * v[j].z + v[j].w * v[j].w); }
        s = wave_sum(s);
        GAS unsigned long long* o8 = (GAS unsigned long long*)(F.XB() + (size_t)m * DM) + F.lane;
#pragma unroll
        for (int j = 0; j < 4; ++j) o8[64 * j] = (unsigned long long)pk2(v[j].x, v[j].y) | ((unsigned long long)pk2(v[j].z, v[j].w) << 32);
        if (F.lane == 0) *(f32x4*)(F.SSQ() + (size_t)m * 4) = (f32x4){s, 0.f, 0.f, 0.f};
    }
    const int gt = F.vcu * 512 + F.tid, NGT = F.G * 512;
    for (int e = gt; e < DEPTH * 2 * 4 * 64 * 64; e += NGT) {
        const int i = e & 63, j = (e >> 6) & 63, g = (e >> 12) & 3, mat = (e >> 14) & 1, l = e >> 15;
        const float* w = mat ? F.lru_wx() : F.lru_wa();
        F.GW()[e] = (bf16)f2bf(w[((size_t)(l * 4 + g) * 64 + i) * 64 + j]);
    }
    for (int e = gt; e < DEPTH * 256; e += NGT) {
        const int l = e >> 8, c = e & 255;
        const float h0 = F.hg_lb()[c], h1 = F.hg_lb()[256 + c], mx = fmaxf(h0, h1), e0 = expf(h0 - mx), e1 = expf(h1 - mx);
        F.LB()[e] = l == 0 ? 0.f : e1 / (e0 + e1);
        const float lam = F.lru_lam()[e]; F.SP()[e] = fmaxf(-lam, 0.f) + log1pf(expf(-fabsf(lam)));
    }
}

constexpr int HB = 72;
constexpr int HS = 68, HS1 = 65;
__device__ __forceinline__ int crow(int r, int hi) { return (r & 3) + 8 * (r >> 2) + 4 * hi; }
__device__ __forceinline__ float fast_sigmoid(float x) { return __builtin_amdgcn_rcpf(1.f + __expf(-x)); }
__device__ __forceinline__ void hg_unit(const Frame& F, int l, int unit, bool fin) {
    const int tid = F.tid, lane = F.lane, wid = F.wave, r32 = lane & 31, hi = lane >> 5;
    const int c = unit & 127, bh = unit >> 7, h = bh & 3, b = bh >> 2;
    const size_t row0 = (size_t)b * T + (size_t)c * 64;
    LAS float* Lb = (LAS float*)F.lds; LAS float* Lx = Lb + 64 * HS1; LAS float* Lo = Lx + 512;
    LAS bf16* Qt = (LAS bf16*)(Lo + 64 * HS); LAS bf16* K0 = Qt + 64 * HB; LAS bf16* K1 = K0 + 32 * HB; LAS bf16* Qe = K1 + 64 * HB;
    LAS bf16* VT = Qe + 64 * HB; LAS bf16* KdT = VT + 64 * HB; LAS bf16* ST = KdT + 64 * HB; LAS bf16* At = ST + 64 * HB;
    const int r = tid >> 3, c8 = (tid & 7) * 8;
    __syncthreads();
    float qs[8], kk[8];
    {
        const bf16* zr = F.Z() + (row0 + r) * DIN + h * 64 + c8;
        float q[8], f[8], v[8];
        unpack8(*(const v4u*)(zr + Z_BQ), q); unpack8(*(const v4u*)(zr + Z_BF), f); unpack8(*(const v4u*)(zr + Z_BI), v);
        const f32x4 lb0 = *(const f32x4*)(F.LB() + l * 256 + h * 64 + c8), lb1 = *(const f32x4*)(F.LB() + l * 256 + h * 64 + c8 + 4);
#pragma unroll
        for (int j = 0; j < 8; ++j) {
            const float lb = j < 4 ? lb0[j & 3] : lb1[j & 3];
            const float e = __expf(-f[j]), rr = __builtin_amdgcn_rcpf(1.f + e);
            const float fg = lb + (1.f - lb) * rr;
            Lb[r * HS1 + c8 + j] = __logf(fmaxf(fg, 1e-37f));
            kk[j] = (1.f - lb) * (e * rr);
            qs[j] = q[j] * fast_sigmoid(q[j]);
            VT[(c8 + j) * HB + r] = (bf16)f2bf(v[j]);
        }
    }
    f32x4 s0 = {0.f, 0.f, 0.f, 0.f}, s1 = {0.f, 0.f, 0.f, 0.f};
    if (fin) { const float* hp = F.HGS() + (size_t)unit * 4096 + r * 64 + c8; s0 = *(const f32x4*)hp; s1 = *(const f32x4*)(hp + 4); }
    __syncthreads();
    {
        const int d = tid & 63, sg = tid >> 6; float run = 0.f;
#pragma unroll
        for (int i = 0; i < 8; ++i) { run += Lb[(sg * 8 + i) * HS1 + d]; Lb[(sg * 8 + i) * HS1 + d] = run; }
        Lx[sg * 64 + d] = run;
        __syncthreads();
        float pre = 0.f;
        for (int s2 = 0; s2 < sg; ++s2) pre += Lx[s2 * 64 + d];
#pragma unroll
        for (int i = 0; i < 8; ++i) Lb[(sg * 8 + i) * HS1 + d] += pre;
    }
    __syncthreads();
    if (!fin) {
#pragma unroll
        for (int j = 0; j < 8; ++j) KdT[(c8 + j) * HB + r] = (bf16)f2bf(kk[j] * __expf(Lb[63 * HS1 + c8 + j] - Lb[r * HS1 + c8 + j]));
        __syncthreads();
        if (wid < 4) {
            const int et = wid >> 1, dt = wid & 1; f32x16 acc;
#pragma unroll
            for (int q_ = 0; q_ < 16; ++q_) acc[q_] = 0.f;
#pragma unroll
            for (int ks = 0; ks < 4; ++ks) { const bf16x8 a = *(const LAS bf16x8*)(VT + (et * 32 + r32) * HB + ks * 16 + hi * 8), bb = *(const LAS bf16x8*)(KdT + (dt * 32 + r32) * HB + ks * 16 + hi * 8);
                acc = __builtin_amdgcn_mfma_f32_32x32x16_bf16(a, bb, acc, 0, 0, 0); }
            float* hp = F.HGS() + (size_t)unit * 4096 + dt * 32 + r32;
#pragma unroll
            for (int q_ = 0; q_ < 16; ++q_) hp[(et * 32 + crow(q_, hi)) * 64] = acc[q_];
        } else if (wid == 4) F.HGD()[unit * 64 + lane] = __expf(Lb[63 * HS1 + lane]);
        return;
    }
    {
        float qt[8], qe[8], k1[8], k0[8];
#pragma unroll
        for (int j = 0; j < 8; ++j) { const float bt = Lb[r * HS1 + c8 + j], b31 = Lb[31 * HS1 + c8 + j], rho = r < 32 ? 0.f : b31;
            qt[j] = qs[j] * __expf(bt - rho); qe[j] = qs[j] * __expf(bt); k1[j] = kk[j] * __expf(fminf(b31 - bt, 80.f)); k0[j] = kk[j] * __expf(fminf(-bt, 80.f)); }
        *(LAS v4u*)(Qt + r * HB + c8) = pack8(qt); *(LAS v4u*)(Qe + r * HB + c8) = pack8(qe); *(LAS v4u*)(K1 + r * HB + c8) = pack8(k1);
        if (r < 32) *(LAS v4u*)(K0 + r * HB + c8) = pack8(k0);
        float sv[8] = {s0[0], s0[1], s0[2], s0[3], s1[0], s1[1], s1[2], s1[3]};
        *(LAS v4u*)(ST + r * HB + c8) = pack8(sv);
    }
    __syncthreads();
    if (wid < 3) {
        const int tb = wid == 0 ? 0 : 32, sb = wid == 2 ? 32 : 0; const LAS bf16* Kp = wid == 0 ? K0 : K1; f32x16 acc;
#pragma unroll
        for (int q_ = 0; q_ < 16; ++q_) acc[q_] = 0.f;
#pragma unroll
        for (int ks = 0; ks < 4; ++ks) { const bf16x8 a = *(const LAS bf16x8*)(Qt + (tb + r32) * HB + ks * 16 + hi * 8), bb = *(const LAS bf16x8*)(Kp + (sb + r32) * HB + ks * 16 + hi * 8);
            acc = __builtin_amdgcn_mfma_f32_32x32x16_bf16(a, bb, acc, 0, 0, 0); }
#pragma unroll
        for (int q_ = 0; q_ < 16; ++q_) { const int tl = crow(q_, hi); const float val = (wid == 1 || r32 <= tl) ? acc[q_] : 0.f; At[(tb + tl) * HB + sb + r32] = (bf16)f2bf(val); }
    }
    __syncthreads();
    if (wid < 4) {
        const int tt = wid >> 1, et = wid & 1; f32x16 acc;
#pragma unroll
        for (int q_ = 0; q_ < 16; ++q_) acc[q_] = 0.f;
#pragma unroll
        for (int ks = 0; ks < 4; ++ks) if (ks < 2 || tt == 1) { const bf16x8 a = *(const LAS bf16x8*)(At + (tt * 32 + r32) * HB + ks * 16 + hi * 8), bb = *(const LAS bf16x8*)(VT + (et * 32 + r32) * HB + ks * 16 + hi * 8);
            acc = __builtin_amdgcn_mfma_f32_32x32x16_bf16(a, bb, acc, 0, 0, 0); }
#pragma unroll
        for (int ks = 0; ks < 4; ++ks) { const bf16x8 a = *(const LAS bf16x8*)(Qe + (tt * 32 + r32) * HB + ks * 16 + hi * 8), bb = *(const LAS bf16x8*)(ST + (et * 32 + r32) * HB + ks * 16 + hi * 8);
            acc = __builtin_amdgcn_mfma_f32_32x32x16_bf16(a, bb, acc, 0, 0, 0); }
#pragma unroll
        for (int q_ = 0; q_ < 16; ++q_) Lo[(tt * 32 + crow(q_, hi)) * HS + et * 32 + r32] = acc[q_];
    }
    __syncthreads();
    {
        const int t = r, e8 = c8; const f32x4 a0 = *(const LAS f32x4*)(Lo + t * HS + e8), a1 = *(const LAS f32x4*)(Lo + t * HS + e8 + 4);
        float acc[8] = {a0[0], a0[1], a0[2], a0[3], a1[0], a1[1], a1[2], a1[3]}; float ss = 0.f;
#pragma unroll
        for (int j = 0; j < 8; ++j) ss += acc[j] * acc[j];
        ss += __shfl_xor(ss, 1); ss += __shfl_xor(ss, 2); ss += __shfl_xor(ss, 4);
        const float rs = rsqrtf(ss * (1.f / 64.f) + EPS);
        float g[8]; unpack8(*(const v4u*)(F.Z() + (row0 + t) * DIN + Z_BG + h * 64 + e8), g);
        const float* nw = F.hg_nw() + l * 64 + e8;
        float o[8];
#pragma unroll
        for (int j = 0; j < 8; ++j) o[j] = acc[j] * rs * nw[j] * (g[j] * fast_sigmoid(g[j]));
        *(v4u*)(F.Y() + (row0 + t) * DM + Y_B + h * 64 + e8) = pack8(o);
    }
}

constexpr int XS = 264;
__device__ __forceinline__ float gelu_tanh(float x) { const float u = 0.7978845608028654f * (x + 0.044715f * x * x * x); const float e = __expf(2.f * u); const float th = 1.f - 2.f / (e + 1.f); return 0.5f * x * (1.f + th); }
__device__ __forceinline__ void lru_unit(const Frame& F, int l, int unit, bool fin) {
    const int tid = F.tid, lane = F.lane, wid = F.wave;
    const int c32 = unit & 255, b = unit >> 8, t0 = c32 * 32; const size_t row0 = (size_t)b * T + t0;
    LAS bf16* Lx = (LAS bf16*)F.lds; LAS float* La = (LAS float*)(F.lds + 32 * XS * 2); LAS float* Lu = La + 32 * 256;
    __syncthreads();
    {
        const int r = tid >> 4, cg = (tid & 15) * 16; float acc[16];
        const float* cb = F.conv_b() + l * 256 + cg; const float* cw = F.conv_w() + (size_t)l * 1024 + cg;
#pragma unroll
        for (int j = 0; j < 16; ++j) acc[j] = cb[j];
#pragma unroll
        for (int k = 0; k < 4; ++k) { const int t = t0 + r - 3 + k;
            if (t >= 0) { const bf16* zr = F.Z() + ((size_t)b * T + t) * DIN + Z_AX + cg; float x0[8], x1[8]; unpack8(*(const v4u*)zr, x0); unpack8(*(const v4u*)(zr + 8), x1);
                const float* w = cw + k * 256;
#pragma unroll
                for (int j = 0; j < 8; ++j) { acc[j] += w[j] * x0[j]; acc[8 + j] += w[8 + j] * x1[j]; } } }
        float a0[8], a1[8];
#pragma unroll
        for (int j = 0; j < 8; ++j) { a0[j] = acc[j]; a1[j] = acc[8 + j]; }
        *(LAS v4u*)(Lx + r * XS + cg) = pack8(a0); *(LAS v4u*)(Lx + r * XS + cg + 8) = pack8(a1);
    }
    __syncthreads();
    {
        const int g = wid >> 1, half = wid & 1, r32 = lane & 31, hi = lane >> 5, chl = half * 32 + r32, ch = g * 64 + chl;
        f32x16 racc, iacc;
#pragma unroll
        for (int r = 0; r < 16; ++r) { racc[r] = 0.f; iacc[r] = 0.f; }
        const bf16* gwa = F.GW() + ((size_t)((l * 2 + 0) * 4 + g) * 64 + chl) * 64; const bf16* gwx = F.GW() + ((size_t)((l * 2 + 1) * 4 + g) * 64 + chl) * 64;
#pragma unroll
        for (int ks = 0; ks < 4; ++ks) {
            const bf16x8 a = *(const LAS bf16x8*)(Lx + r32 * XS + g * 64 + ks * 16 + hi * 8);
            const bf16x8 ba = *(const bf16x8*)(gwa + ks * 16 + hi * 8), bx = *(const bf16x8*)(gwx + ks * 16 + hi * 8);
            racc = __builtin_amdgcn_mfma_f32_32x32x16_bf16(a, ba, racc, 0, 0, 0); iacc = __builtin_amdgcn_mfma_f32_32x32x16_bf16(a, bx, iacc, 0, 0, 0);
        }
        const float bav = F.lru_ba()[l * 256 + ch], bxv = F.lru_bx()[l * 256 + ch], spv = F.SP()[l * 256 + ch];
#pragma unroll
        for (int r = 0; r < 16; ++r) { const int tok = crow(r, hi);
            const float xcv = bf1(Lx[tok * XS + ch]);
            const float rg = sigmoidf_(racc[r] + bav), ig = sigmoidf_(iacc[r] + bxv);
            const float la = -8.f * rg * spv, av = __expf(la), mult = sqrtf(-expm1f(2.f * la));
            La[tok * 256 + ch] = av; Lu[tok * 256 + ch] = mult * ig * xcv; }
    }
    __syncthreads();
    if (tid < 256) {
        const int ch = tid; float hc = fin ? F.LRUC()[unit * 256 + ch] : 0.f, P = 1.f;
#pragma unroll 8
        for (int t = 0; t < 32; ++t) { const float av = La[t * 256 + ch], uv = Lu[t * 256 + ch]; hc = av * hc + uv; P *= av; if (fin) Lu[t * 256 + ch] = hc; }
        if (!fin) { F.LRUA()[unit * 256 + ch] = P; F.LRUU()[unit * 256 + ch] = hc; }
    }
    if (!fin) return;
    __syncthreads();
    {
        const int r = tid >> 4, cg = (tid & 15) * 16; const bf16* zr = F.Z() + (row0 + r) * DIN + Z_AY + cg; float g0[8], g1[8]; unpack8(*(const v4u*)zr, g0); unpack8(*(const v4u*)(zr + 8), g1);
        float v0[8], v1[8], ss = 0.f;
#pragma unroll
        for (int j = 0; j < 8; ++j) { v0[j] = Lu[r * 256 + cg + j] * gelu_tanh(g0[j]); v1[j] = Lu[r * 256 + cg + 8 + j] * gelu_tanh(g1[j]); ss += v0[j] * v0[j] + v1[j] * v1[j]; }
        ss += __shfl_xor(ss, 1); ss += __shfl_xor(ss, 2); ss += __shfl_xor(ss, 4); ss += __shfl_xor(ss, 8);
        const float rs = rsqrtf(ss * (1.f / 256.f) + EPS);
#pragma unroll
        for (int j = 0; j < 8; ++j) { v0[j] *= rs; v1[j] *= rs; }
        bf16* yr = F.Y() + (row0 + r) * DM + Y_A + cg; *(v4u*)yr = pack8(v0); *(v4u*)(yr + 8) = pack8(v1);
    }
}

__device__ __forceinline__ void kmean_unit(const Frame& F, int unit) {
    const int q = unit & 3, n = (unit >> 2) & 31, b = unit >> 7, rg = F.tid >> 6, ch = F.tid & 63;
    LAS float* part = (LAS float*)F.lds;
    __syncthreads();
    const bf16* zp = F.Z() + ((size_t)b * T + (size_t)n * 256 + q * 64 + rg * 8) * DIN + Z_CK + ch * 8; float s[8];
#pragma unroll
    for (int j = 0; j < 8; ++j) s[j] = 0.f;
#pragma unroll
    for (int r = 0; r < 8; ++r) { float t8[8]; unpack8(*(const v4u*)(zp + (size_t)r * DIN), t8);
#pragma unroll
        for (int j = 0; j < 8; ++j) s[j] += t8[j]; }
    *(LAS f32x4*)(part + rg * 512 + ch * 8) = (f32x4){s[0], s[1], s[2], s[3]}; *(LAS f32x4*)(part + rg * 512 + ch * 8 + 4) = (f32x4){s[4], s[5], s[6], s[7]};
    __syncthreads();
    float t = 0.f;
#pragma unroll
    for (int g = 0; g < 8; ++g) t += part[g * 512 + F.tid];
    F.KMP()[(size_t)unit * 512 + F.tid] = t;
}
__device__ __forceinline__ void select_unit(const Frame& F, int item) {
    const int hp = item & 3, j = (item >> 2) & 31, b = item >> 7, hsel = F.tid >> 8, h = hp * 2 + hsel, tok = F.tid & 255;
    LAS float* km = (LAS float*)F.lds;
    __syncthreads();
#pragma unroll
    for (int i = 0; i < 8; ++i) { const int e = i * 512 + F.tid, hs = e >> 11, n = (e >> 6) & 31, dd = e & 63; const float* kp = F.KMP() + ((size_t)(b * 32 + n) * 4) * 512 + (hp * 2 + hs) * 64 + dd;
        km[e] = ((kp[0] + kp[512]) + (kp[1024] + kp[1536])) * (1.f / 256.f); }
    __syncthreads();
    const size_t row = (size_t)b * T + (size_t)j * 256 + tok;
    float q[64];
#pragma unroll
    for (int i = 0; i < 8; ++i) { float t8[8]; unpack8(*(const v4u*)(F.Z() + row * DIN + Z_CQ + h * 64 + i * 8), t8);
#pragma unroll
        for (int e = 0; e < 8; ++e) q[i * 8 + e] = t8[e]; }
    float v1 = -INFINITY, v2 = -INFINITY, v3 = -INFINITY; int i1 = -1, i2 = -1, i3 = -1;
    for (int n = 0; n < j; ++n) { const LAS float* kp = km + (hsel * 32 + n) * 64; float g = 0.f;
#pragma unroll
        for (int d = 0; d < 64; d += 4) { const f32x4 kv = *(const LAS f32x4*)(kp + d); g += q[d] * kv[0] + q[d + 1] * kv[1] + q[d + 2] * kv[2] + q[d + 3] * kv[3]; }
        if (g > v1) { v3 = v2; i3 = i2; v2 = v1; i2 = i1; v1 = g; i1 = n; }
        else if (g > v2) { v3 = v2; i3 = i2; v2 = g; i2 = n; }
        else if (g > v3) { v3 = g; i3 = n; } }
    unsigned msk = 0u; if (i1 >= 0) msk |= 1u << i1; if (i2 >= 0) msk |= 1u << i2; if (i3 >= 0) msk |= 1u << i3;
    F.SEL()[row * 8 + h] = msk;
}

__device__ __forceinline__ void hg_scan_item(const Frame& F, int item) {
    const int el = F.tid & 63, grp = F.tid >> 6, e = item * 64 + el, seq = e >> 12, de = e & 4095, dd = de & 63;
    LAS float* gS = (LAS float*)F.lds; LAS float* gD = gS + 512;
    __syncthreads();
    float Hc[16], Dc[16]; float* hp = F.HGS() + (size_t)(seq * 128 + grp * 16) * 4096 + de; const float* dp = F.HGD() + (seq * 128 + grp * 16) * 64 + dd;
#pragma unroll
    for (int i = 0; i < 16; ++i) { Hc[i] = hp[(size_t)i * 4096]; Dc[i] = dp[i * 64]; }
    float s = 0.f, pd = 1.f;
#pragma unroll
    for (int i = 0; i < 16; ++i) { s = Dc[i] * s + Hc[i]; pd *= Dc[i]; }
    gS[grp * 64 + el] = s; gD[grp * 64 + el] = pd;
    __syncthreads();
    float cy = 0.f;
    for (int g = 0; g < grp; ++g) cy = gD[g * 64 + el] * cy + gS[g * 64 + el];
#pragma unroll
    for (int i = 0; i < 16; ++i) { hp[(size_t)i * 4096] = cy; cy = Dc[i] * cy + Hc[i]; }
}
__device__ __forceinline__ void lru_scan_item(const Frame& F, int item) {
    const int sl = F.tid & 31, grp = F.tid >> 5, sidx = item * 32 + sl, b = sidx >> 8, ch = sidx & 255;
    LAS float* gA = (LAS float*)F.lds; LAS float* gU = gA + 512;
    __syncthreads();
    float A[16], U[16]; const int u0 = (b * 256 + grp * 16) * 256 + ch;
#pragma unroll
    for (int i = 0; i < 16; ++i) { A[i] = F.LRUA()[u0 + i * 256]; U[i] = F.LRUU()[u0 + i * 256]; }
    float pa = 1.f, pu = 0.f;
#pragma unroll
    for (int i = 0; i < 16; ++i) { pu = A[i] * pu + U[i]; pa *= A[i]; }
    gA[grp * 32 + sl] = pa; gU[grp * 32 + sl] = pu;
    __syncthreads();
    float cy = 0.f;
    for (int g = 0; g < grp; ++g) cy = gA[g * 32 + sl] * cy + gU[g * 32 + sl];
#pragma unroll
    for (int i = 0; i < 16; ++i) { F.LRUC()[u0 + i * 256] = cy; cy = A[i] * cy + U[i]; }
}

namespace moba {
typedef LAS const char* lds_cptr;
typedef short v4i16_t __attribute__((ext_vector_type(4)));
constexpr int SLOTB = 8192, LDS_K = 0, LDS_V = 2 * SLOTB, LDS_WS = 4 * SLOTB, LDS_OST = LDS_WS + NWAVES * 256, LDS_FLAG = LDS_OST + NWAVES * 4096;
__device__ __forceinline__ void glds16(const void* gsrc, unsigned lds_dst) { unsigned keep;
    asm volatile("s_mov_b32 %0, m0\n\ts_mov_b32 m0, %2\n\ts_nop 0\n\tglobal_load_lds_dwordx4 %1, off\n\ts_mov_b32 m0, %0" : "=&s"(keep) : "v"(gsrc), "s"(lds_dst) : "memory"); }
typedef float f32x2_t __attribute__((ext_vector_type(2))); typedef __bf16 bf16x2_t __attribute__((ext_vector_type(2)));
__device__ __forceinline__ unsigned cvtpk_s(float lo, float hi) { f32x2_t v = {lo, hi}; bf16x2_t b = __builtin_convertvector(v, bf16x2_t); return __builtin_bit_cast(unsigned, b); }
#define MX3(a, b, c) __builtin_fmaxf(__builtin_fmaxf((a), (b)), (c))
__device__ __forceinline__ float rowmax(const f32x16& p0, const f32x16& p1) {
    float a = MX3(p0[0], p0[1], p1[0]), b = MX3(p0[2], p0[3], p1[1]); a = MX3(a, p1[2], p1[3]);
#pragma unroll
    for (int r = 4; r < 16; r += 4) { a = MX3(a, p0[r], p0[r + 1]); b = MX3(b, p0[r + 2], p0[r + 3]); a = MX3(a, p1[r], p1[r + 1]); b = MX3(b, p1[r + 2], p1[r + 3]); }
    float m = __builtin_fmaxf(a, b); auto rr = __builtin_amdgcn_permlane32_swap(__float_as_uint(m), __float_as_uint(m), false, false);
    return __builtin_fmaxf(__uint_as_float(rr[0]), __uint_as_float(rr[1])); }
#undef MX3
__device__ __forceinline__ void qkt(f32x16& p0, f32x16& p1, lds_cptr kb, const bf16x8* qr, const f32x16& c0) {
#pragma unroll
    for (int d0 = 0; d0 < 4; ++d0) {
        const bf16x8 b0 = *(const LAS bf16x8*)(kb + d0 * 2048), b1 = *(const LAS bf16x8*)(kb + d0 * 2048 + 512);
        if (d0 == 0) { p0 = __builtin_amdgcn_mfma_f32_32x32x16_bf16(b0, qr[0], c0, 0, 0, 0); p1 = __builtin_amdgcn_mfma_f32_32x32x16_bf16(b1, qr[0], c0, 0, 0, 0); }
        else { p0 = __builtin_amdgcn_mfma_f32_32x32x16_bf16(b0, qr[d0], p0, 0, 0, 0); p1 = __builtin_amdgcn_mfma_f32_32x32x16_bf16(b1, qr[d0], p1, 0, 0, 0); } }
}
__device__ __forceinline__ void pv(f32x16* o, int vb, bf16x8 pa0, bf16x8 pa1, bf16x8 pa2, bf16x8 pa3) {
#pragma unroll
    for (int d0 = 0; d0 < 2; ++d0) { s16x4 lo[4], hi[4];
#pragma unroll
        for (int ks = 0; ks < 4; ++ks) {
            asm volatile("ds_read_b64_tr_b16 %0,%1 offset:%c2" : "=&v"(lo[ks]) : "v"(vb), "i"(d0 * 4096 + ks * 1024) : "memory");
            asm volatile("ds_read_b64_tr_b16 %0,%1 offset:%c2" : "=&v"(hi[ks]) : "v"(vb), "i"(d0 * 4096 + ks * 1024 + 512) : "memory"); }
        asm volatile("s_waitcnt lgkmcnt(0)" ::: "memory"); __builtin_amdgcn_sched_barrier(0);
#define PK(k) (bf16x8){lo[k][0], lo[k][1], lo[k][2], lo[k][3], hi[k][0], hi[k][1], hi[k][2], hi[k][3]}
        o[d0] = __builtin_amdgcn_mfma_f32_32x32x16_bf16(pa0, PK(0), o[d0], 0, 0, 0);
        o[d0] = __builtin_amdgcn_mfma_f32_32x32x16_bf16(pa1, PK(1), o[d0], 0, 0, 0);
        o[d0] = __builtin_amdgcn_mfma_f32_32x32x16_bf16(pa2, PK(2), o[d0], 0, 0, 0);
        o[d0] = __builtin_amdgcn_mfma_f32_32x32x16_bf16(pa3, PK(3), o[d0], 0, 0, 0);
#undef PK
    }
}
__device__ __forceinline__ void attn_unit(const Frame& F, int b, int h, int jb) {
    LAS char* shm = (LAS char*)F.lds;
    const int lane = F.lane, r32 = lane & 31, hi = lane >> 5, wid = F.wave;
    const long rowbase = (long)b * T; const int q0 = jb * 256;
    const bf16* Qw = F.Z() + (rowbase + q0 + wid * 32) * DIN + Z_CQ + h * 64;
    const bf16* Kh = F.Z() + rowbase * DIN + Z_CK + h * 64; const bf16* Vh = F.Z() + rowbase * DIN + Z_CV + h * 64;
    const unsigned lds0 = (unsigned)(uintptr_t)shm;
    LAS float* wsf = (LAS float*)(shm + LDS_WS) + wid * 64;
    const bf16* ksrc = Kh + (long)lane * DIN + wid * 8;
    const bf16* vsrc = Vh + (long)(16 * (wid & 3) + (lane >> 2)) * DIN + (wid >> 2) * 32 + (lane & 3) * 8;
    const unsigned kdst = lds0 + LDS_K + wid * 1024, vdst = lds0 + LDS_V + wid * 1024;
#define DMA_K(pt, slot) glds16(ksrc + (long)(pt) * 64 * DIN, (unsigned)__builtin_amdgcn_readfirstlane(kdst + (slot)))
#define DMA_V(pt, slot) glds16(vsrc + (long)(pt) * 64 * DIN, (unsigned)__builtin_amdgcn_readfirstlane(vdst + (slot)))
    const int vb0 = (int)(lds0 + LDS_V) + ((lane >> 4) & 1) * 32 + (lane & 3) * 8 + (4 * hi + ((lane & 15) >> 2)) * 64;
    const lds_cptr kp0 = (lds_cptr)shm + LDS_K + hi * 1024 + r32 * 16;
    bf16x8 qr[4];
#pragma unroll
    for (int d0 = 0; d0 < 4; ++d0) qr[d0] = *(const bf16x8*)(Qw + (long)r32 * DIN + d0 * 16 + hi * 8);
    const int qrel = wid * 32 + r32;
    const unsigned selm = F.SEL()[(size_t)(rowbase + q0 + qrel) * 8 + h];
    unsigned wor = selm;
#pragma unroll
    for (int o_ = 1; o_ < 32; o_ <<= 1) wor |= (unsigned)__shfl_xor((int)wor, o_);
    LAS unsigned* flg = (LAS unsigned*)(shm + LDS_FLAG);
    __syncthreads();
    if (lane == 0) flg[wid] = wor;
    __syncthreads();
    unsigned rem = 0u;
#pragma unroll
    for (int w = 0; w < NWAVES; ++w) rem |= flg[w];
    rem = (unsigned)__builtin_amdgcn_readfirstlane((int)rem);
    const float beta = exp2f(-(float)(h + 1)) * LOG2E;
    float mhat = 0.f, l_reg = 0.f; f32x16 o[2];
#pragma unroll
    for (int r = 0; r < 16; ++r) { o[0][r] = 0.f; o[1][r] = 0.f; }
    int blk = jb, ti = 0, slot = 0; bool first = true;
    DMA_K(4 * blk, 0); DMA_V(4 * blk, 0);
    for (;;) {
        int nblk = blk, nti = ti + 1; bool has_next = true;
        if (nti == 4) { if (rem) { nblk = __builtin_ctz(rem); rem &= rem - 1u; nti = 0; } else has_next = false; }
        asm volatile("s_waitcnt vmcnt(0) lgkmcnt(0)\n\ts_barrier" ::: "memory");
        if (has_next) { DMA_K(4 * nblk + nti, (slot ^ 1) * SLOTB); DMA_V(4 * nblk + nti, (slot ^ 1) * SLOTB); }
        f32x16 negm;
#pragma unroll
        for (int r = 0; r < 16; ++r) negm[r] = -mhat;
        f32x16 p0, p1; qkt(p0, p1, kp0 + slot * SLOTB, qr, negm);
        const int pt = 4 * blk + ti;
        if (blk == jb) {
            const int kb = 64 * ti + 4 * hi;
#pragma unroll
            for (int r = 0; r < 16; ++r) { const int kv = kb + (r & 3) + 8 * (r >> 2); if (kv > qrel) p0[r] = -INFINITY; if (kv + 32 > qrel) p1[r] = -INFINITY; }
        } else if (!((selm >> blk) & 1u)) {
#pragma unroll
            for (int r = 0; r < 16; ++r) { p0[r] = -INFINITY; p1[r] = -INFINITY; }
        }
        const float ab = beta * (float)(64 * pt + 4 * hi - (q0 + qrel));
#pragma unroll
        for (int r = 0; r < 16; ++r) { const float cr = (float)((r & 3) + 8 * (r >> 2)); p0[r] += ab + beta * cr; p1[r] += ab + beta * (cr + 32.f); }
        const float rm = rowmax(p0, p1);
        bool resc = false;
        if (first || __any(rm > 0.f)) {
            const float dl = first ? rm : fmaxf(rm, 0.f); mhat += dl;
#pragma unroll
            for (int r = 0; r < 16; ++r) { p0[r] -= dl; p1[r] -= dl; }
            if (!first) { const float f = __builtin_amdgcn_exp2f(-dl); l_reg *= f; if (hi == 0) wsf[r32] = f; resc = true; }
        }
        if (resc) {
#pragma unroll
            for (int d_ = 0; d_ < 2; ++d_)
#pragma unroll
                for (int r = 0; r < 16; ++r) o[d_][r] *= wsf[crow(r, hi)];
        }
        float sacc = 0.f;
#pragma unroll
        for (int r = 0; r < 16; ++r) { p0[r] = __builtin_amdgcn_exp2f(p0[r]); p1[r] = __builtin_amdgcn_exp2f(p1[r]); sacc += p0[r] + p1[r]; }
        l_reg += sacc;
        v4u pw0, pw1, pw2, pw3;
#define PKW(P, B) cvtpk_s(P[B], P[B + 1])
        pw0 = (v4u){PKW(p0, 0), PKW(p0, 2), PKW(p0, 4), PKW(p0, 6)}; pw1 = (v4u){PKW(p0, 8), PKW(p0, 10), PKW(p0, 12), PKW(p0, 14)};
        pw2 = (v4u){PKW(p1, 0), PKW(p1, 2), PKW(p1, 4), PKW(p1, 6)}; pw3 = (v4u){PKW(p1, 8), PKW(p1, 10), PKW(p1, 12), PKW(p1, 14)};
#undef PKW
        __builtin_amdgcn_sched_barrier(0);
        pv(o, vb0 + slot * SLOTB, __builtin_bit_cast(bf16x8, pw0), __builtin_bit_cast(bf16x8, pw1), __builtin_bit_cast(bf16x8, pw2), __builtin_bit_cast(bf16x8, pw3));
        first = false;
        if (!has_next) break;
        blk = nblk; ti = nti; slot ^= 1;
    }
#undef DMA_K
#undef DMA_V
    { auto rr = __builtin_amdgcn_permlane32_swap(__float_as_uint(l_reg), __float_as_uint(l_reg), false, false); l_reg = __uint_as_float(rr[0]) + __uint_as_float(rr[1]); }
    if (hi == 0) wsf[32 + r32] = l_reg;
    float rli[16];
#pragma unroll
    for (int r = 0; r < 16; ++r) rli[r] = 1.f / wsf[32 + crow(r, hi)];
    LAS bf16* stg = (LAS bf16*)(shm + LDS_OST) + wid * 2048;
#pragma unroll
    for (int r = 0; r < 16; ++r) { const int orow = crow(r, hi);
#pragma unroll
        for (int d0 = 0; d0 < 2; ++d0) stg[orow * 64 + d0 * 32 + r32] = (bf16)f2bf(o[d0][r] * rli[r]); }
    bf16* Ow = F.Y() + (rowbase + q0 + wid * 32) * DM + Y_C + h * 64;
#pragma unroll
    for (int i = 0; i < 4; ++i) { const int row = i * 8 + (lane >> 3), ch = lane & 7; const v4u v = *(const LAS v4u*)(stg + row * 64 + ch * 8); *(v4u*)(Ow + (long)row * DM + ch * 8) = v; }
}

constexpr int F_K = 0, F_V = 3 * SLOTB, F_WS = 6 * SLOTB, F_OST = F_WS + NWAVES * 256, F_TAB = F_OST + NWAVES * 4096, F_FLAG = F_TAB + 256;
#define SBAR() __builtin_amdgcn_sched_barrier(0)
#define WAIT_BAR(N) asm volatile("s_waitcnt vmcnt(" #N ") lgkmcnt(0)\n\ts_barrier":::"memory")
__device__ __forceinline__ void kload8(bf16x8* kf, lds_cptr kp) {
    kf[0] = *(const LAS bf16x8*)(kp);        kf[1] = *(const LAS bf16x8*)(kp + 512);
    kf[2] = *(const LAS bf16x8*)(kp + 2048); kf[3] = *(const LAS bf16x8*)(kp + 2560);
    kf[4] = *(const LAS bf16x8*)(kp + 4096); kf[5] = *(const LAS bf16x8*)(kp + 4608);
    kf[6] = *(const LAS bf16x8*)(kp + 6144); kf[7] = *(const LAS bf16x8*)(kp + 6656);
}
__device__ __forceinline__ void kload2(bf16x8* kf, lds_cptr kp, int j) { kf[2 * j] = *(const LAS bf16x8*)(kp + j * 2048); kf[2 * j + 1] = *(const LAS bf16x8*)(kp + j * 2048 + 512); }
__device__ __forceinline__ s16x4 vtr(lds_cptr p) { return __builtin_bit_cast(s16x4, __builtin_amdgcn_ds_read_tr16_b64_v4i16((LAS v4i16_t*)p)); }
__device__ __forceinline__ void glds16s(const void* sbase, unsigned voff, unsigned lds_dst) { unsigned keep;
    asm volatile("s_mov_b32 %0, m0\n\ts_mov_b32 m0, %3\n\ts_nop 0\n\tglobal_load_lds_dwordx4 %1, %2\n\ts_mov_b32 m0, %0" : "=&s"(keep) : "v"(voff), "s"(sbase), "s"(lds_dst) : "memory"); }
template <int THRL> __device__ __forceinline__ void attn_unit_fast(const Frame& F, int b, int h, int jb) {
    LAS char* shm = (LAS char*)F.lds;
    const int lane = F.lane, r32 = lane & 31, hi = lane >> 5, wid = F.wave;
    const long rowbase = (long)b * T; const int q0 = jb * 256;
    const bf16* Qw = F.Z() + (rowbase + q0 + wid * 32) * DIN + Z_CQ + h * 64;
    const bf16* Kh = F.Z() + rowbase * DIN + Z_CK + h * 64; const bf16* Vh = F.Z() + rowbase * DIN + Z_CV + h * 64;
    const unsigned lds0 = (unsigned)(uintptr_t)shm;
    LAS float* wsf = (LAS float*)(shm + F_WS) + wid * 64;
    const unsigned koff = (unsigned)(lane * DIN + wid * 8) * 2u;
    const unsigned voff = (unsigned)((16 * (wid & 3) + (lane >> 2)) * DIN + (wid >> 2) * 32 + (lane & 3) * 8) * 2u;
    const unsigned kdst = lds0 + F_K + wid * 1024, vdst = lds0 + F_V + wid * 1024;
#define DMA_K(pt, slot) glds16s(Kh + (long)(pt) * 64 * DIN, koff, (unsigned)__builtin_amdgcn_readfirstlane(kdst + (slot)))
#define DMA_V(pt, slot) glds16s(Vh + (long)(pt) * 64 * DIN, voff, (unsigned)__builtin_amdgcn_readfirstlane(vdst + (slot)))
    const int vb0 = (int)(lds0 + F_V) + ((lane >> 4) & 1) * 32 + (lane & 3) * 8 + (4 * hi + ((lane & 15) >> 2)) * 64;
    const lds_cptr shm3 = (lds_cptr)shm; const lds_cptr kp0 = shm3 + F_K + hi * 1024 + r32 * 16; const lds_cptr vp0 = shm3 + F_V + ((lane >> 4) & 1) * 32 + (lane & 3) * 8 + (4 * hi + ((lane & 15) >> 2)) * 64;
    const int qrel = wid * 32 + r32;
    const unsigned selm = F.SEL()[(size_t)(rowbase + q0 + qrel) * 8 + h];
    unsigned wor = selm;
#pragma unroll
    for (int o_ = 1; o_ < 32; o_ <<= 1) wor |= (unsigned)__shfl_xor((int)wor, o_);
    LAS unsigned* flg = (LAS unsigned*)(shm + F_FLAG); LAS int* tab = (LAS int*)(shm + F_TAB);
    __syncthreads();
    if (lane == 0) flg[wid] = wor;
    __syncthreads();
    unsigned rem = 0u;
#pragma unroll
    for (int w = 0; w < NWAVES; ++w) rem |= flg[w];
    rem = (unsigned)__builtin_amdgcn_readfirstlane((int)rem);
    if (F.tid == 0) tab[0] = jb;
    if (F.tid >= 1 && F.tid <= 32 && ((rem >> (F.tid - 1)) & 1u)) tab[1 + __builtin_popcount(rem & ((1u << (F.tid - 1)) - 1u))] = F.tid - 1;
    __syncthreads();
    const int NT = 4 * (1 + __builtin_popcount(rem));
#define PT(t) (4 * __builtin_amdgcn_readfirstlane(tab[((t) >> 2) & 63]) + ((t) & 3))
    DMA_K(PT(0), 0); DMA_V(PT(0), 0); DMA_K(PT(1), SLOTB);
    bf16x8 qr[4];
#pragma unroll
    for (int d0 = 0; d0 < 4; ++d0) qr[d0] = *(const bf16x8*)(Qw + (long)r32 * DIN + d0 * 16 + hi * 8);
    const float beta = __uint_as_float((unsigned)__builtin_amdgcn_readfirstlane((int)__float_as_uint(exp2f(-(float)(h + 1)) * LOG2E)));
    const float qoff = (float)(4 * hi - (q0 + qrel));
    float mhat = 0.f, l_reg = 0.f; f32x16 o[2];
#pragma unroll
    for (int r = 0; r < 16; ++r) { o[0][r] = 0.f; o[1][r] = 0.f; }
#define INITC(C0, C1, t) do { const int bc_ = __builtin_amdgcn_readfirstlane(tab[((t) >> 2) & 63]); const bool on_ = (bc_ == jb) || ((selm >> bc_) & 1u); \
        const float ct_ = on_ ? __builtin_fmaf(beta, (float)(64 * (4 * bc_ + ((t) & 3))) + qoff, -mhat) : -1e30f; \
        _Pragma("unroll") for (int r = 0; r < 16; ++r) { const float cr_ = (float)((r & 3) + 8 * (r >> 2)); C0[r] = __builtin_fmaf(beta, cr_, ct_); C1[r] = __builtin_fmaf(beta, cr_ + 32.f, ct_); } } while (0)
#define CMASK(P0, P1, t) do { if ((t) < 4) { const int kb_ = 64 * (t) + 4 * hi; \
        _Pragma("unroll") for (int r = 0; r < 16; ++r) { const int kv_ = kb_ + (r & 3) + 8 * (r >> 2); if (kv_ > qrel) P0[r] = -INFINITY; if (kv_ + 32 > qrel) P1[r] = -INFINITY; } } } while (0)
    bool resc = false;
#define RESC() do { if (resc) { asm volatile("s_waitcnt lgkmcnt(0)" ::: "memory"); \
        _Pragma("unroll") for (int d_ = 0; d_ < 2; ++d_) _Pragma("unroll") for (int r = 0; r < 16; ++r) o[d_][r] *= wsf[crow(r, hi)]; } } while (0)
    f32x16 pA0, pA1, pB0, pB1;
    int sl_prev = 0, sl_cur = 0, sl_next = SLOTB;
#define ROT() do { sl_prev = sl_cur; sl_cur = sl_next; sl_next = (sl_next == 2 * SLOTB) ? 0 : sl_next + SLOTB; } while (0)
    DMA_K(PT(2), 2 * SLOTB);
    WAIT_BAR(3);
    INITC(pA0, pA1, 0);
    { f32x16 c0 = pA0, c1 = pA1;
#pragma unroll
      for (int d0 = 0; d0 < 4; ++d0) { const bf16x8 b0 = *(const LAS bf16x8*)(kp0 + d0 * 2048), b1 = *(const LAS bf16x8*)(kp0 + d0 * 2048 + 512);
          c0 = __builtin_amdgcn_mfma_f32_32x32x16_bf16(b0, qr[d0], c0, 0, 0, 0); c1 = __builtin_amdgcn_mfma_f32_32x32x16_bf16(b1, qr[d0], c1, 0, 0, 0); }
      pA0 = c0; pA1 = c1; }
    CMASK(pA0, pA1, 0);
    { const float dl = rowmax(pA0, pA1); mhat += dl;
#pragma unroll
      for (int r = 0; r < 16; ++r) { pA0[r] = __builtin_amdgcn_exp2f(pA0[r] - dl); pA1[r] = __builtin_amdgcn_exp2f(pA1[r] - dl); } }
    WAIT_BAR(0);
    DMA_K(PT(3), 0); DMA_V(PT(1), SLOTB);
    ROT();
    bf16x8 kf[8];
    kload8(kf, kp0 + sl_cur);
    WAIT_BAR(2);
  s16x4 vlo[8],vhi[8]; v4u pw0,pw1,pw2,pw3;
  #define PKW(P,B) cvtpk_s(P[B],P[B+1])
  #define PAF(k) __builtin_bit_cast(bf16x8,pw##k)
  #define VFR(i) (bf16x8){vlo[i][0],vlo[i][1],vlo[i][2],vlo[i][3],vhi[i][0],vhi[i][1],vhi[i][2],vhi[i][3]}
  #define PIN(x) asm volatile("":"+v"(x))
  #define MX3(a,b,c) __builtin_fmaxf(__builtin_fmaxf((a),(b)),(c))
  #define GAPA(MF,A0,A1,A2,A3,W0,W1,PW) do{ MF; sacc+=A0; sacc+=A1; sacc+=A2; sacc+=A3; PIN(sacc); W0; W1; PIN(PW); SBAR(); }while(0)
  #define EX(v) __builtin_amdgcn_exp2f(v)
  #define GAPB(MF,X,B) do{ MF; X[B]=EX(X[B]); X[B+1]=EX(X[B+1]); X[B+2]=EX(X[B+2]); X[B+3]=EX(X[B+3]); PIN(X); SBAR(); }while(0)
  #define VRD(i) do{ vlo[i]=vtr(vp_+(((i)>>2)*4096+((i)&3)*1024)); vhi[i]=vtr(vp_+(((i)>>2)*4096+((i)&3)*1024+512)); }while(0)
  #define KRD(G,j) do{ if(G){ kload2(kf,kp0+sl_next,j); SBAR(); } }while(0)
  #define STEP(C0,C1,P0,P1,t,GK,GV,GL) do{ INITC(C0,C1,t); SBAR(); \
    const lds_cptr vp_=vp0+sl_prev; \
    VRD(0); SBAR(); float sacc=(P0[0]+P0[1]); \
    GAPA(C0=__builtin_amdgcn_mfma_f32_32x32x16_bf16(kf[0],qr[0],C0,0,0,0), P0[2],P0[3],P0[4],P0[5],     pw0[0]=PKW(P0,0), pw0[1]=PKW(P0,2), pw0); \
    VRD(4); SBAR(); GAPA(C1=__builtin_amdgcn_mfma_f32_32x32x16_bf16(kf[1],qr[0],C1,0,0,0), P0[6],P0[7],P0[8],P0[9],     pw0[2]=PKW(P0,4), pw0[3]=PKW(P0,6), pw0); \
    VRD(1); SBAR(); GAPA(C0=__builtin_amdgcn_mfma_f32_32x32x16_bf16(kf[2],qr[1],C0,0,0,0),   P0[10],P0[11],P0[12],P0[13], pw1[0]=PKW(P0,8), pw1[1]=PKW(P0,10), pw1); \
    VRD(5); SBAR(); GAPA(C1=__builtin_amdgcn_mfma_f32_32x32x16_bf16(kf[3],qr[1],C1,0,0,0),   P0[14],P0[15],P1[0],P1[1],   pw1[2]=PKW(P0,12),pw1[3]=PKW(P0,14), pw1); \
    VRD(2); SBAR(); GAPA(C0=__builtin_amdgcn_mfma_f32_32x32x16_bf16(kf[4],qr[2],C0,0,0,0),   P1[2],P1[3],P1[4],P1[5],     pw2[0]=PKW(P1,0), pw2[1]=PKW(P1,2), pw2); \
    VRD(6); SBAR(); GAPA(C1=__builtin_amdgcn_mfma_f32_32x32x16_bf16(kf[5],qr[2],C1,0,0,0),   P1[6],P1[7],P1[8],P1[9],     pw2[2]=PKW(P1,4), pw2[3]=PKW(P1,6), pw2); \
    VRD(3); SBAR(); GAPA(C0=__builtin_amdgcn_mfma_f32_32x32x16_bf16(kf[6],qr[3],C0,0,0,0),   P1[10],P1[11],P1[12],P1[13], pw3[0]=PKW(P1,8), pw3[1]=PKW(P1,10), pw3); \
    VRD(7); SBAR(); GAPA(C1=__builtin_amdgcn_mfma_f32_32x32x16_bf16(kf[7],qr[3],C1,0,0,0),   P1[14],P1[15],0.f,0.f,       pw3[2]=PKW(P1,12),pw3[3]=PKW(P1,14), pw3); \
    l_reg+=sacc; \
    if(GK){DMA_K(PT((t)+3),sl_cur);} if(GV){DMA_V(PT((t)+1),sl_next);} \
    CMASK(C0,C1,t); \
    { float a=MX3(C0[0],C0[1],C1[0]),b=MX3(C0[2],C0[3],C1[1]); a=MX3(a,C1[2],C1[3]); \
      _Pragma("unroll") for(int r=4;r<16;r+=4){a=MX3(a,C0[r],C0[r+1]);b=MX3(b,C0[r+2],C0[r+3]);a=MX3(a,C1[r],C1[r+1]);b=MX3(b,C1[r+2],C1[r+3]);} \
      float rm=__builtin_fmaxf(a,b); { auto rr=__builtin_amdgcn_permlane32_swap(__float_as_uint(rm),__float_as_uint(rm),false,false); rm=__builtin_fmaxf(__uint_as_float(rr[0]),__uint_as_float(rr[1])); } \
      resc=false; \
      if(__builtin_expect(__any(rm>(float)THRL),0)){ const float dl=__builtin_fmaxf(rm,0.f); mhat+=dl; \
        _Pragma("unroll") for(int r=0;r<16;++r){C0[r]-=dl;C1[r]-=dl;} \
        const float f=__builtin_amdgcn_exp2f(-dl); l_reg*=f; if(hi==0)wsf[r32]=f; resc=true; } } \
    SBAR(); \
    GAPB(o[0]=__builtin_amdgcn_mfma_f32_32x32x16_bf16(PAF(0),VFR(0),o[0],0,0,0), C0,0); \
    GAPB(o[1]=__builtin_amdgcn_mfma_f32_32x32x16_bf16(PAF(0),VFR(4),o[1],0,0,0), C0,4); \
    KRD(GL,0); GAPB(o[0]=__builtin_amdgcn_mfma_f32_32x32x16_bf16(PAF(1),VFR(1),o[0],0,0,0), C0,8); \
    KRD(GL,1); GAPB(o[1]=__builtin_amdgcn_mfma_f32_32x32x16_bf16(PAF(1),VFR(5),o[1],0,0,0), C0,12); \
    KRD(GL,2); GAPB(o[0]=__builtin_amdgcn_mfma_f32_32x32x16_bf16(PAF(2),VFR(2),o[0],0,0,0), C1,0); \
    KRD(GL,3); GAPB(o[1]=__builtin_amdgcn_mfma_f32_32x32x16_bf16(PAF(2),VFR(6),o[1],0,0,0), C1,4); \
    GAPB(o[0]=__builtin_amdgcn_mfma_f32_32x32x16_bf16(PAF(3),VFR(3),o[0],0,0,0), C1,8); \
    GAPB(o[1]=__builtin_amdgcn_mfma_f32_32x32x16_bf16(PAF(3),VFR(7),o[1],0,0,0), C1,12); \
    }while(0)

#define ENDW(tt) do { if ((tt) + 3 < NT) { WAIT_BAR(2); } else if ((tt) + 2 < NT) { WAIT_BAR(1); } else { WAIT_BAR(0); } } while (0)
    int t = 1;
    for (; t + 1 < NT; t += 2) {
        STEP(pB0, pB1, pA0, pA1, t, (t + 3 < NT), (t + 1 < NT), (t + 1 < NT));       ENDW(t);     RESC(); ROT();
        STEP(pA0, pA1, pB0, pB1, t + 1, (t + 4 < NT), (t + 2 < NT), (t + 2 < NT));   ENDW(t + 1); RESC(); ROT();
    }
    STEP(pB0, pB1, pA0, pA1, NT - 1, false, false, false); RESC();
    { float sacc = pB0[0] + pB0[1];
#pragma unroll
      for (int r = 2; r < 16; ++r) sacc += pB0[r];
#pragma unroll
      for (int r = 0; r < 16; ++r) sacc += pB1[r];
      l_reg += sacc;
      pw0 = (v4u){PKW(pB0, 0), PKW(pB0, 2), PKW(pB0, 4), PKW(pB0, 6)}; pw1 = (v4u){PKW(pB0, 8), PKW(pB0, 10), PKW(pB0, 12), PKW(pB0, 14)};
      pw2 = (v4u){PKW(pB1, 0), PKW(pB1, 2), PKW(pB1, 4), PKW(pB1, 6)}; pw3 = (v4u){PKW(pB1, 8), PKW(pB1, 10), PKW(pB1, 12), PKW(pB1, 14)};
      SBAR(); pv(o, vb0 + sl_cur, PAF(0), PAF(1), PAF(2), PAF(3)); }
#undef PKW
#undef PAF
#undef VFR
#undef PIN
#undef MX3
#undef GAPA
#undef GAPB
#undef EX
#undef VRD
#undef KRD
#undef STEP
#undef ENDW
    { auto rr = __builtin_amdgcn_permlane32_swap(__float_as_uint(l_reg), __float_as_uint(l_reg), false, false); l_reg = __uint_as_float(rr[0]) + __uint_as_float(rr[1]); }
    if (hi == 0) wsf[32 + r32] = l_reg;
    asm volatile("s_waitcnt lgkmcnt(0)" ::: "memory");
    float rli[16];
#pragma unroll
    for (int r = 0; r < 16; ++r) rli[r] = __builtin_amdgcn_rcpf(wsf[32 + crow(r, hi)]);
    LAS bf16* stg = (LAS bf16*)(shm + F_OST) + wid * 2048;
#pragma unroll
    for (int r = 0; r < 16; ++r) { const int orow = crow(r, hi);
#pragma unroll
        for (int d0 = 0; d0 < 2; ++d0) stg[orow * 64 + d0 * 32 + r32] = (bf16)f2bf(o[d0][r] * rli[r]); }
    asm volatile("s_waitcnt lgkmcnt(0)" ::: "memory");
    bf16* Ow = F.Y() + (rowbase + q0 + wid * 32) * DM + Y_C + h * 64;
#pragma unroll
    for (int i = 0; i < 4; ++i) { const int row = i * 8 + (lane >> 3), ch = lane & 7; const v4u v = *(const LAS v4u*)(stg + row * 64 + ch * 8); *(v4u*)(Ow + (long)row * DM + ch * 8) = v; }
    asm volatile("s_waitcnt lgkmcnt(0)\n\ts_barrier" ::: "memory");
#undef DMA_K
#undef DMA_V
#undef PT
#undef INITC
#undef CMASK
#undef RESC
#undef ROT
}
#undef SBAR
#undef WAIT_BAR
}

__device__ __forceinline__ void ycnorm_rows(const Frame& F) {
    const int gw = F.vcu * NWAVES + F.wave, NGW = F.G * NWAVES;
    for (int m = gw; m < M; m += NGW) { bf16* p = F.Y() + (size_t)m * DM + Y_C + F.lane * 8; float v[8]; unpack8(*(const v4u*)p, v); float s = 0.f;
#pragma unroll
        for (int j = 0; j < 8; ++j) s += v[j] * v[j];
        s = wave_sum(s); const float rs = rsqrtf(s * (1.f / 512.f) + EPS);
#pragma unroll
        for (int j = 0; j < 8; ++j) v[j] *= rs;
        *(v4u*)p = pack8(v); }
}
__device__ __forceinline__ void final_norm_rows(const Frame& F) {
    const int gw = F.vcu * NWAVES + F.wave, NGW = F.G * NWAVES;
    for (int m = gw; m < M; m += NGW) { GAS f32x4* xr = (GAS f32x4*)(F.out + (size_t)m * DM) + F.lane; const f32x4 s4 = *(const f32x4*)(F.SSQ() + (size_t)m * 4);
        const float rs = rsqrtf(((s4[0] + s4[1]) + (s4[2] + s4[3])) * (1.f / DM) + EPS);
#pragma unroll
        for (int j = 0; j < 4; ++j) { const f32x4 g = *((const f32x4*)F.norm_final() + F.lane + 64 * j); xr[64 * j] = xr[64 * j] * rs * g; } }
}

struct Args { const float* in[19]; float* out; unsigned char* ws; int ph_lo, ph_hi, use_bar, pad; };
__global__ void __launch_bounds__(NWAVES * 64, 2) mk_fwd(Args args) {
    __shared__ __attribute__((aligned(16))) unsigned char lds[LDS_BYTES];
    Frame F;
    F.lds = (LAS unsigned char*)lds;
    F.tid = threadIdx.x; F.lane = F.tid & 63; F.wave = __builtin_amdgcn_readfirstlane(F.tid >> 6);
    F.G = gridDim.x; { const int bx = blockIdx.x; F.vcu = (F.G % 8 == 0) ? (bx % 8) * (F.G / 8) + bx / 8 : bx; }
    const int vcu0 = F.vcu;
    F.ka = (const unsigned char*)__builtin_amdgcn_kernarg_segment_ptr(); F.ws = args.ws; F.out = args.out;
    unsigned char* ws = args.ws;
    for (int u = F.tid; u < (LDS_BYTES - LDSCTL_OFF) / 4; u += NWAVES * 64) ((LAS unsigned*)(F.lds + LDSCTL_OFF))[u] = 0u;
    __syncthreads();
    XcdBarrier bar; bar.bar = (unsigned*)(ws + WS_CTL) + CW_BAR; bar.x = 0; bar.st = nullptr;
    if (args.use_bar) bar = xcd_barrier_post((unsigned*)(ws + WS_CTL) + CW_BAR, (volatile LAS unsigned*)(F.lds + MISC_OFF) + 8);

    bool dup_done = false; (void)dup_done;
    for (int ph = args.ph_lo; ph < args.ph_hi; ++ph) {
        {
            int t_ = threadIdx.x; asm volatile("" : "+v"(t_)); F.tid = t_; F.lane = t_ & 63; F.wave = __builtin_amdgcn_readfirstlane(t_ >> 6);
            int v_ = vcu0; asm volatile("" : "+s"(v_)); F.vcu = v_;
            unsigned char* w_ = args.ws; asm volatile("" : "+s"(w_)); F.ws = w_;
            float* o_ = args.out; asm volatile("" : "+s"(o_)); F.out = o_;
        }
        const int l = (ph - 1) >> 3, k = (ph == 0) ? -1 : (ph == NPH - 1 ? 8 : ((ph - 1) & 7));
        if (k == -1) {
            p0_prologue(F);
        } else if (k == 0) {
            pg8::Gemm g{F.XB(), F.WIN() + (size_t)l * DIN * DM, M, DIN, DM}; pg8::StaticOrder S; S.init(M, DIN, F.G, (int)blockIdx.x);
            pg8::EpiScale<0> E{F.Z(), DIN, F.SSQ(), 1.f / DM, EPS, Z_CQ, Z_CK, C2};
            pg8::gemm_phase<pg8::EpiScale<0>, pg8::StaticOrder, true, true>(F.lds, g, S, E);
        } else if (k == 1) {
            for (int it = F.vcu; it < 1024 + 512 + 256; it += F.G) {
                if (it < 1024) hg_unit(F, l, it, false);
                else if (it < 1536) lru_unit(F, l, it - 1024, false);
                else kmean_unit(F, it - 1536);
            }
        } else if (k == 2) {
            for (int it = F.vcu; it < 256 + 512 + 16; it += F.G) {
                if (it < 256) select_unit(F, it);
                else if (it < 768) hg_scan_item(F, it - 256);
                else lru_scan_item(F, it - 768);
            }
        } else if (k == 3) {
            { const int bh = F.vcu >> 4, s = F.vcu & 15;
              if (bh < 16) { moba::attn_unit_fast<8>(F, bh >> 3, bh & 7, 31 - s); moba::attn_unit_fast<8>(F, bh >> 3, bh & 7, s); } }
            for (int it = F.vcu; it < 1024 + 512; it += F.G) {
                if (it < 1024) hg_unit(F, l, it, true); else lru_unit(F, l, it - 1024, true);
            }
        } else if (k == 4) {
#if defined(DBG_REP4)
            if (DBG_REP4 == 2) for (int it = F.vcu; it < 1024; it += F.G) hg_unit(F, l, it, true);
            if (DBG_REP4 == 3) for (int it = F.vcu; it < 512; it += F.G) lru_unit(F, l, it, true);
            __syncthreads();
#endif
            ycnorm_rows(F);
        } else if (k == 5) {
            pg8::Gemm g{F.Y(), F.WOUT() + (size_t)l * DM * DM, M, DM, DM}; pg8::StaticOrder S; S.init(M, DM, F.G, (int)blockIdx.x);
            pg8::EpiRes E{l == 0 ? F.x() : F.out, F.out, F.XB(), F.SSQ(), DM};
            pg8::gemm_phase<pg8::EpiRes, pg8::StaticOrder, false, true>(F.lds, g, S, E);
        } else if (k == 6) {
            pg8::Gemm g{F.XB(), F.W1() + (size_t)l * FF * DM, M, FF, DM}; pg8::StaticOrder S; S.init(M, FF, F.G, (int)blockIdx.x);
            pg8::EpiScale<1> E{F.H(), FF, F.SSQ(), 1.f / DM, EPS, 0, 0, 1.f};
            pg8::gemm_phase<pg8::EpiScale<1>, pg8::StaticOrder, true, true>(F.lds, g, S, E);
        } else if (k == 7) {
            pg8::Gemm g{F.H(), F.W2() + (size_t)l * DM * FF, M, DM, FF}; pg8::StaticOrder S; S.init(M, DM, F.G, (int)blockIdx.x);
            pg8::EpiRes E{F.out, F.out, F.XB(), F.SSQ(), DM};
            pg8::gemm_phase<pg8::EpiRes, pg8::StaticOrder, false, true>(F.lds, g, S, E);
        } else {
            final_norm_rows(F);
        }
        if (ph + 1 < args.ph_hi) xcd_barrier(bar);
#if defined(DBG_DUP)
        if (k == DBG_DUP && !dup_done) { dup_done = true; --ph; } else dup_done = false;
#endif
    }
}


#ifndef DBG_STOP
#define DBG_STOP 0
#endif
#if DBG_STOP
__global__ void dbg_dump(float* out, const unsigned char* ws, int keep_out) {
    const size_t n = (size_t)M * DM;
    for (size_t i = (size_t)blockIdx.x * blockDim.x + threadIdx.x; i < n; i += (size_t)gridDim.x * blockDim.x) {
        float v = 0.f; if (keep_out) { float t = out[i]; v = (t == t && fabsf(t) < 1e30f) ? t : 1e21f; }
        const bf16* big = (const bf16*)(ws + WS_Z);
        for (int q = 0; q < 4; ++q) { float t = bf1(big[i + (size_t)q * n]); const int cc = (int)(i % 1024); const float sen = q < 3 ? 1e9f : (cc < 256 ? 1e12f : (cc < 512 ? 1e15f : 1e18f)); v += (t == t && fabsf(t) < 1e30f) ? t : sen; }
        const float* sm = (const float*)(ws + 1 * MiB); { const size_t si = i % (4 * MiB / 4); float t = (si >= 128 * 1024 && si < 256 * 1024) ? 0.f : sm[si]; v += (t == t && fabsf(t) < 1e30f) ? t : 1e12f; }
        const float* hs = (const float*)(ws + WS_HGS); { float t = hs[i % (16 * MiB / 4)]; v += (t == t && fabsf(t) < 1e30f) ? t : 1e15f; }
        const bf16* xb = (const bf16*)(ws + WS_XB); { float t = bf1(xb[i]); v += (t == t && fabsf(t) < 1e30f) ? t : 1e18f; }
        out[i] = v;
    }
}
#endif
extern "C" void kernel_launch(void* const* d_in, const int* in_sizes, int n_in, void* d_out, int out_size, void* d_ws, size_t ws_size, hipStream_t stream) {
    if (n_in != 19 || out_size != M * DM || ws_size < WS_END) { fprintf(stderr, "kernel_launch: unexpected shapes (n_in %d, out %d, ws %zu)\n", n_in, out_size, ws_size); return; }
    const int grid = 256;
    (void)hipMemsetAsync((char*)d_ws + WS_CTL, 0, CTL_ZERO_BYTES, stream);
    Args a{};
    for (int i = 0; i < 19; ++i) a.in[i] = (const float*)d_in[i];
    a.out = (float*)d_out; a.ws = (unsigned char*)d_ws;
#if MK_ONE_LAUNCH
    a.ph_lo = 0; a.ph_hi = NPH; a.use_bar = 1;
    hipLaunchKernelGGL(mk_fwd, dim3(grid), dim3(NWAVES * 64), 0, stream, a);
#else
#if DBG_STOP
    const int nph = DBG_STOP;
#else
    const int nph = NPH;
#endif
    for (int ph = 0; ph < nph; ++ph) { a.ph_lo = ph; a.ph_hi = ph + 1; a.use_bar = 0; hipLaunchKernelGGL(mk_fwd, dim3(grid), dim3(NWAVES * 64), 0, stream, a); }
#if DBG_STOP
    hipLaunchKernelGGL(dbg_dump, dim3(2048), dim3(256), 0, stream, (float*)d_out, (const unsigned char*)d_ws, (int)(DBG_STOP >= 7));
#endif
#endif
}
```

```cpp
#include <hip/hip_runtime.h>
#include <hip/hip_bf16.h>
#include <cstdio>
#include <cstdint>
#include <cmath>
namespace pg8 {
#define PG8_LAS __attribute__((address_space(3)))
typedef unsigned short bf16_t;
typedef short bf16x8 __attribute__((ext_vector_type(8)));
typedef float f32x4 __attribute__((ext_vector_type(4)));
typedef unsigned u32x4 __attribute__((ext_vector_type(4)));
constexpr int BM = 256, BK = 64, HALF = 128, HTB = HALF * BK * 2  , STAGE_BYTES = 8 * HTB, NXCD = 8, WGM = 8;

__host__ __device__ __forceinline__ int lds_byte(int r, int c) { const int st = (r >> 4) * 2 + (c >> 5), rr = r & 15, cc = c & 31, ob = rr * 64 + cc * 2; return st * 1024 + (ob ^ (((ob >> 9) & 1) << 5)); }
__host__ __device__ __forceinline__ void stage_rc(int b, int& R, int& C) { const int st = b / 1024, sb = b % 1024, swz = sb ^ (((sb >> 9) & 1) << 5); R = (st >> 1) * 16 + swz / 64; C = (st & 1) * 32 + (swz % 64) / 2; }
__host__ __device__ __forceinline__ int perm32(int rho) { const int n = rho >> 4, i = rho & 15; return 8 * (i >> 2) + 4 * n + (i & 3); }

struct Unit { int pm, pn; };
struct Gemm { const bf16_t* A; const bf16_t* Bt; int M, N, K; };

struct StaticOrder {
    int nM, nN, nwg, G, c;
    __host__ __device__ void init(int M, int N, int G_, int c_) { nM = M / BM; nN = N / BM; nwg = nM * nN; G = G_; c = c_; }
    __host__ __device__ bool next(int i, Unit& u) const {
        const long L = (long)i * G + c; if (L >= nwg) return false;
        int wgid = (int)L; { const int q = nwg / NXCD, r = nwg % NXCD, xcd = wgid % NXCD, off = wgid / NXCD; wgid = (xcd < r ? xcd * (q + 1) : r * (q + 1) + (xcd - r) * q) + off; }
        const int nig = WGM * nN, gid = wgid / nig, fm = gid * WGM, gsz = (nM - fm) < WGM ? (nM - fm) : WGM;
        u.pm = fm + ((wgid % nig) % gsz); u.pn = (wgid % nig) / gsz; return true;
    }
    __device__ __forceinline__ void a_ready(const Unit&) const {}
    __device__ __forceinline__ void done(const Unit&) const {}
};
__device__ __forceinline__ unsigned cvt_pk_bf16(float lo, float hi) { unsigned r; asm volatile("v_cvt_pk_bf16_f32 %0, %1, %2" : "=v"(r) : "v"(lo), "v"(hi)); return r; }
typedef float f32x2 __attribute__((ext_vector_type(2)));
typedef unsigned u32x2 __attribute__((ext_vector_type(2)));
template <int ACT> struct EpiScale {
    static constexpr bool PERM = true, AFTER_DRAIN = false;
    bf16_t* O; int ldc; const float* ssq; float inv_k, eps; int sc_lo, sc_hi; float sc;
    __device__ __forceinline__ void operator()(const f32x4 (&acc)[2][2][4][2], const Unit& u, int wr, int wc, int fr, int fq) const {
        const int row0 = u.pm * BM + wr * 64 + fr; const int colt = u.pn * BM;
        const float cs = (colt >= sc_lo && colt < sc_hi) ? sc : 1.f;
        const int col0 = colt + wc * 32 + 8 * fq;
#pragma unroll
        for (int ai = 0; ai < 2; ++ai)
#pragma unroll
            for (int m = 0; m < 4; ++m) { const int row = row0 + ai * HALF + m * 16;
                const f32x4 s4 = *(const f32x4*)(ssq + (size_t)row * 4);
                const float rs = rsqrtf(((s4[0] + s4[1]) + (s4[2] + s4[3])) * inv_k + eps) * cs;
                bf16_t* rowp = O + (size_t)row * ldc + col0;
#pragma unroll
                for (int bj = 0; bj < 2; ++bj) { f32x4 v0 = acc[ai][bj][m][0] * rs, v1 = acc[ai][bj][m][1] * rs;
                    if (ACT == 1) {
#pragma unroll
                        for (int e = 0; e < 4; ++e) { const float a0 = fmaxf(v0[e], 0.f), a1 = fmaxf(v1[e], 0.f); v0[e] = a0 * a0; v1[e] = a1 * a1; } }
                    u32x4 w; w.x = cvt_pk_bf16(v0[0], v0[1]); w.y = cvt_pk_bf16(v0[2], v0[3]); w.z = cvt_pk_bf16(v1[0], v1[1]); w.w = cvt_pk_bf16(v1[2], v1[3]);
                    *(u32x4*)(rowp + bj * HALF) = w; } }
    }
};
struct EpiRes {
    static constexpr bool PERM = false, AFTER_DRAIN = true;
    const float* base; float* out; bf16_t* xb; float* ssq; int ldc;
    __device__ __forceinline__ void fused(f32x4 (&acc)[2][2][4][2], const Unit& u, int wr, int wc, int fr, int fq, PG8_LAS unsigned char* lds, int wid, int lane) const {
        PG8_LAS float* P = (PG8_LAS float*)lds;
#if defined(DBG_ZACC)
#pragma unroll
        for (int a_ = 0; a_ < 2; ++a_)
#pragma unroll
            for (int b_ = 0; b_ < 2; ++b_)
#pragma unroll
                for (int m_ = 0; m_ < 4; ++m_)
#pragma unroll
                    for (int n_ = 0; n_ < 2; ++n_) acc[a_][b_][m_][n_] = (f32x4){0.f, 0.f, 0.f, 0.f};
#endif
        const int col0 = u.pn * BM + wc * 32 + 4 * fq;
#pragma unroll
        for (int ai = 0; ai < 2; ++ai)
#pragma unroll
            for (int m = 0; m < 4; ++m) { const int r = ai * HALF + wr * 64 + m * 16 + fr; const size_t off = (size_t)(u.pm * BM + r) * ldc + col0; float ps = 0.f;
#pragma unroll
                for (int bj = 0; bj < 2; ++bj)
#pragma unroll
                    for (int n = 0; n < 2; ++n) { const f32x4 bs = *(const f32x4*)(base + off + bj * HALF + n * 16); const f32x4 o = bs + acc[ai][bj][m][n];
                        *(f32x4*)(out + off + bj * HALF + n * 16) = o; ps += (o[0] * o[0] + o[1] * o[1]) + (o[2] * o[2] + o[3] * o[3]);
                        u32x2 w; w.x = cvt_pk_bf16(o[0], o[1]); w.y = cvt_pk_bf16(o[2], o[3]); *(u32x2*)(xb + off + bj * HALF + n * 16) = w; }
                ps += __shfl_xor(ps, 16); ps += __shfl_xor(ps, 32);
                if (fq == 0) P[r * 4 + wc] = ps;
                if (m & 1) asm volatile("" ::: "memory"); }
        __syncthreads();
        const int t = wid * 64 + lane;
        if (t < 256) ssq[(size_t)(u.pm * BM + t) * 4 + u.pn] = (P[t * 4] + P[t * 4 + 1]) + (P[t * 4 + 2] + P[t * 4 + 3]);
    }
};
template <class Epi, class Sched, bool ALIGN_EPI = false, bool SP2 = false>
__device__ __forceinline__ void gemm_phase(PG8_LAS unsigned char* lds, const Gemm g, const Sched& S, const Epi& E, const int tid_in) {
    int tid_l = tid_in; asm volatile("" : "+v"(tid_l));
    const int tid = tid_l, wid = __builtin_amdgcn_readfirstlane(tid >> 6), lane = tid & 63, wr = wid >> 2, wc = wid & 3, fr = lane & 15, fq = lane >> 4;
    const int K = g.K, nt = K / BK;
    unsigned voffA[2], voffB[2];
#pragma unroll
    for (int i = 0; i < 2; ++i) { int R, C; stage_rc(tid * 16 + i * 8192, R, C); const int Rb = Epi::PERM ? ((R & ~31) + perm32(R & 31)) : R;
        voffA[i] = (unsigned)(R * K + C) * 2u; voffB[i] = (unsigned)(Rb * K + C) * 2u; }
    const size_t kstep = (size_t)(BK * 2);
    const size_t hstep = (size_t)HALF * K * 2;
    const size_t tstep = 2 * hstep;
    const unsigned ldsw = (unsigned)wid * 1024u;
    const int aoff = lds_byte(wr * 64 + fr, fq * 8), boff = lds_byte(wc * 32 + fr, fq * 8);
#define PG8_SA(b, h) (((b) * 2 + (h)) * HTB)
#define PG8_SB(b, h) ((4 + (b) * 2 + (h)) * HTB)
#define PG8_STAGE(bufoff, gbase, voff) do { _Pragma("unroll") for (int _i = 0; _i < 2; ++_i) \
        __builtin_amdgcn_global_load_lds((const unsigned*)((const char*)(gbase) + (voff)[_i]), (PG8_LAS unsigned*)(lds + (bufoff) + ldsw + _i * 8192), 16, 0, 0); } while (0)
#define PG8_LDA(dst, b, h) do { _Pragma("unroll") for (int m = 0; m < 4; ++m) _Pragma("unroll") for (int k = 0; k < 2; ++k) dst[m][k] = *(const PG8_LAS bf16x8*)(lds + PG8_SA(b, h) + aoff + m * 2048 + k * 1024); } while (0)
#define PG8_LDB(dst, b, h) do { _Pragma("unroll") for (int n = 0; n < 2; ++n) _Pragma("unroll") for (int k = 0; k < 2; ++k) dst[n][k] = *(const PG8_LAS bf16x8*)(lds + PG8_SB(b, h) + boff + n * 2048 + k * 1024); } while (0)
#define PG8_MMA(ai, bj, At, Bt) do { __builtin_amdgcn_s_setprio(1); _Pragma("unroll") for (int m = 0; m < 4; ++m) _Pragma("unroll") for (int n = 0; n < 2; ++n) _Pragma("unroll") for (int k = 0; k < 2; ++k) \
        acc[ai][bj][m][n] = __builtin_amdgcn_mfma_f32_16x16x32_bf16(Bt[n][k], At[m][k], acc[ai][bj][m][n], 0, 0, 0); __builtin_amdgcn_s_setprio(0); } while (0)
#define PG8_WAIT_V(n) asm volatile("s_waitcnt vmcnt(" #n ")" ::: "memory")
#define PG8_WAIT_L(n) asm volatile("s_waitcnt lgkmcnt(" #n ")" ::: "memory")
#define PG8_BAR __builtin_amdgcn_s_barrier()
#define PG8_SCHED __builtin_amdgcn_sched_barrier(0)
    Unit cur, nxt; int ui = 0;
    if (!S.next(0, cur)) return;
    f32x4 acc[2][2][4][2];
#pragma unroll
    for (int a = 0; a < 2; ++a)
#pragma unroll
        for (int b = 0; b < 2; ++b)
#pragma unroll
            for (int m = 0; m < 4; ++m)
#pragma unroll
                for (int n = 0; n < 2; ++n) acc[a][b][m][n] = (f32x4){0.f, 0.f, 0.f, 0.f};
    bf16x8 At[4][2], B0[2][2], B1[2][2];
    const char* cA = (const char*)g.A + (size_t)cur.pm * tstep; const char* cB = (const char*)g.Bt + (size_t)cur.pn * tstep;
    S.a_ready(cur);
    if constexpr (SP2) {
        PG8_STAGE(PG8_SB(0, 0), cB, voffB); PG8_STAGE(PG8_SB(0, 1), cB + hstep, voffB); PG8_STAGE(PG8_SA(0, 0), cA, voffA); PG8_STAGE(PG8_SA(0, 1), cA + hstep, voffA);
        if (wr == 1) PG8_BAR;
        PG8_WAIT_V(2); PG8_BAR;
        PG8_STAGE(PG8_SB(1, 0), cB + kstep, voffB); PG8_STAGE(PG8_SA(1, 0), cA + kstep, voffA); PG8_STAGE(PG8_SB(1, 1), cB + hstep + kstep, voffB);
        PG8_WAIT_V(6); PG8_BAR;
    } else {
        PG8_STAGE(PG8_SB(0, 0), cB, voffB); PG8_STAGE(PG8_SA(0, 0), cA, voffA); PG8_STAGE(PG8_SB(0, 1), cB + hstep, voffB); PG8_STAGE(PG8_SA(0, 1), cA + hstep, voffA);
        if (wr == 1) PG8_BAR;
        PG8_WAIT_V(4); PG8_BAR;
        PG8_STAGE(PG8_SB(1, 0), cB + kstep, voffB); PG8_STAGE(PG8_SA(1, 0), cA + kstep, voffA); PG8_STAGE(PG8_SB(1, 1), cB + hstep + kstep, voffB);
        PG8_WAIT_V(6); PG8_BAR;
    }
    for (;;) {
        const bool has_next = S.next(ui + 1, nxt);
        const char* nA = has_next ? (const char*)g.A + (size_t)nxt.pm * tstep : cA; const char* nB = has_next ? (const char*)g.Bt + (size_t)nxt.pn * tstep : cB;
        for (int t = 0; t < nt; t += 2) {
            const bool last = (t == nt - 2);
            const char* a1 = cA + (size_t)(t + 1) * kstep;
            const char* a2 = last ? nA : cA + (size_t)(t + 2) * kstep; const char* b2 = last ? nB : cB + (size_t)(t + 2) * kstep;
            const char* a3 = a2 + kstep; const char* b3 = b2 + kstep;
            if (last && has_next) S.a_ready(nxt);
            if constexpr (SP2) {
            PG8_LDB(B0, 0, 0); PG8_LDB(B1, 0, 1); PG8_SCHED; PG8_LDA(At, 0, 0); PG8_STAGE(PG8_SA(1, 1), a1 + hstep, voffA);
            PG8_WAIT_V(8); PG8_WAIT_L(0); PG8_BAR; PG8_MMA(0, 0, At, B0); PG8_MMA(0, 1, At, B1); PG8_BAR; PG8_SCHED;
            PG8_LDA(At, 0, 1); PG8_STAGE(PG8_SB(0, 0), b2, voffB); PG8_STAGE(PG8_SB(0, 1), b2 + hstep, voffB); PG8_STAGE(PG8_SA(0, 0), a2, voffA);
            PG8_WAIT_V(8); PG8_WAIT_L(0); PG8_BAR; PG8_MMA(1, 0, At, B0); PG8_MMA(1, 1, At, B1); PG8_BAR; PG8_SCHED;
            PG8_LDB(B0, 1, 0); PG8_LDB(B1, 1, 1); PG8_SCHED; PG8_LDA(At, 1, 0); PG8_STAGE(PG8_SA(0, 1), a2 + hstep, voffA);
            PG8_WAIT_V(8); PG8_WAIT_L(0); PG8_BAR; PG8_MMA(0, 0, At, B0); PG8_MMA(0, 1, At, B1); PG8_BAR; PG8_SCHED;
            PG8_LDA(At, 1, 1); PG8_STAGE(PG8_SB(1, 0), b3, voffB); PG8_STAGE(PG8_SB(1, 1), b3 + hstep, voffB); PG8_STAGE(PG8_SA(1, 0), a3, voffA);
            PG8_WAIT_V(8); PG8_WAIT_L(0); PG8_BAR; PG8_MMA(1, 0, At, B0); PG8_MMA(1, 1, At, B1); PG8_BAR; PG8_SCHED;
            } else {
            PG8_LDB(B0, 0, 0); PG8_SCHED; PG8_LDA(At, 0, 0); PG8_STAGE(PG8_SA(1, 1), a1 + hstep, voffA);
            PG8_WAIT_L(8); PG8_BAR; PG8_WAIT_L(0); PG8_MMA(0, 0, At, B0); PG8_BAR; PG8_SCHED;
            PG8_LDB(B1, 0, 1); PG8_STAGE(PG8_SB(0, 0), b2, voffB);
            PG8_BAR; PG8_WAIT_L(0); PG8_MMA(0, 1, At, B1); PG8_BAR;
            PG8_LDA(At, 0, 1); PG8_STAGE(PG8_SA(0, 0), a2, voffA);
            PG8_BAR; PG8_WAIT_L(0); PG8_MMA(1, 0, At, B0); PG8_BAR; PG8_SCHED;
            PG8_STAGE(PG8_SB(0, 1), b2 + hstep, voffB);
            PG8_WAIT_V(6); PG8_BAR; PG8_MMA(1, 1, At, B1); PG8_BAR;
            PG8_LDB(B0, 1, 0); PG8_SCHED; PG8_LDA(At, 1, 0); PG8_STAGE(PG8_SA(0, 1), a2 + hstep, voffA);
            PG8_WAIT_L(8); PG8_BAR; PG8_WAIT_L(0); PG8_MMA(0, 0, At, B0); PG8_BAR; PG8_SCHED;
            PG8_LDB(B1, 1, 1); PG8_STAGE(PG8_SB(1, 0), b3, voffB);
            PG8_BAR; PG8_WAIT_L(0); PG8_MMA(0, 1, At, B1); PG8_BAR;
            PG8_LDA(At, 1, 1); PG8_STAGE(PG8_SA(1, 0), a3, voffA);
            PG8_BAR; PG8_WAIT_L(0); PG8_MMA(1, 0, At, B0); PG8_BAR; PG8_SCHED;
            PG8_STAGE(PG8_SB(1, 1), b3 + hstep, voffB);
            PG8_WAIT_V(6); PG8_BAR; PG8_MMA(1, 1, At, B1); PG8_BAR;
            }
        }
        if constexpr (ALIGN_EPI) { if (wr == 0) PG8_BAR; }
        if constexpr (!Epi::AFTER_DRAIN) { E(acc, cur, wr, wc, fr, fq); S.done(cur); }
        if (!has_next) break;
#pragma unroll
        for (int a = 0; a < 2; ++a)
#pragma unroll
            for (int b = 0; b < 2; ++b)
#pragma unroll
                for (int m = 0; m < 4; ++m)
#pragma unroll
                    for (int n = 0; n < 2; ++n) acc[a][b][m][n] = (f32x4){0.f, 0.f, 0.f, 0.f};
        cur = nxt; cA = nA; cB = nB; ++ui;
        if constexpr (ALIGN_EPI) { if (wr == 1) PG8_BAR; }
    }
    PG8_WAIT_V(0);
    if constexpr (!ALIGN_EPI) { if (wr == 0) PG8_BAR; }
    PG8_BAR;
    if constexpr (Epi::AFTER_DRAIN) { E.fused(acc, cur, wr, wc, fr, fq, lds, wid, lane); S.done(cur); }
#undef PG8_SA
#undef PG8_SB
#undef PG8_STAGE
#undef PG8_LDA
#undef PG8_LDB
#undef PG8_MMA
#undef PG8_WAIT_V
#undef PG8_WAIT_L
#undef PG8_BAR
#undef PG8_SCHED
}
}

constexpr int NWAVES = 8;
constexpr int BATCH = 2, T = 8192, DM = 1024, M = BATCH * T, DIN = 3072, FF = 4096, DEPTH = 2;
constexpr int Z_AX = 0, Z_AY = 256, Z_BQ = 512, Z_BF = 768, Z_BI = 1024, Z_BG = 1280, Z_CQ = 1536, Z_CK = 2048, Z_CV = 2560;
constexpr int Y_A = 0, Y_B = 256, Y_C = 512;
constexpr float EPS = 1e-6f;
constexpr float LOG2E = 1.4426950408889634f;
constexpr float C2 = 0.125f * LOG2E;
constexpr int NPH = 18;
#ifndef MK_ONE_LAUNCH
#define MK_ONE_LAUNCH 1
#endif

constexpr size_t MiB = 1u << 20, KiB = 1024;
constexpr size_t WS_CTL = 0, CTL_ZERO_BYTES = 64 * KiB;
constexpr size_t WS_SSQ = 1 * MiB;
constexpr size_t WS_KMP = 5 * MiB;
constexpr size_t WS_SEL = 1 * MiB + 512 * KiB;
constexpr size_t WS_LRUA = 2 * MiB;
constexpr size_t WS_LRUU = 2 * MiB + 512 * KiB;
constexpr size_t WS_LRUC = 3 * MiB;
constexpr size_t WS_HGD = 3 * MiB + 512 * KiB;
constexpr size_t WS_GW = 4 * MiB;
constexpr size_t WS_LB = 4 * MiB + 256 * KiB;
constexpr size_t WS_SP = 4 * MiB + 260 * KiB;
constexpr size_t WS_WIN = 8 * MiB;
constexpr size_t WS_WOUT = 20 * MiB;
constexpr size_t WS_W1 = 24 * MiB;
constexpr size_t WS_W2 = 40 * MiB;
constexpr size_t WS_XB = 56 * MiB;
constexpr size_t WS_HGS = 88 * MiB;
constexpr size_t WS_Z = 104 * MiB;
constexpr size_t WS_Y = 200 * MiB;
constexpr size_t WS_H = 104 * MiB;
constexpr size_t WS_END = 232 * MiB;
constexpr int CW_BAR = 1024;

constexpr int RING_BYTES = 131072, LDSCTL_OFF = RING_BYTES, MISC_OFF = LDSCTL_OFF + 320, LDS_BYTES = 147456;

#define GAS __attribute__((address_space(1)))
#define LAS __attribute__((address_space(3)))
typedef unsigned short bf16;
typedef unsigned v4u __attribute__((ext_vector_type(4)));
typedef float f32x4 __attribute__((ext_vector_type(4)));
typedef short bf16x8 __attribute__((ext_vector_type(8)));
typedef float f32x16 __attribute__((ext_vector_type(16)));
typedef short s16x4 __attribute__((ext_vector_type(4)));
#define RLX_AGENT __ATOMIC_RELAXED, __HIP_MEMORY_SCOPE_AGENT
__device__ __forceinline__ unsigned f2bf(float f) { unsigned u = __builtin_bit_cast(unsigned, f); return (u + 0x7fffu + ((u >> 16) & 1u)) >> 16; }
__device__ __forceinline__ unsigned pk2(float lo, float hi) { return f2bf(lo) | (f2bf(hi) << 16); }
__device__ __forceinline__ float bflo(unsigned u) { return __uint_as_float(u << 16); }
__device__ __forceinline__ float bfhi(unsigned u) { return __uint_as_float(u & 0xffff0000u); }
__device__ __forceinline__ float bf1(bf16 v) { return __uint_as_float((unsigned)v << 16); }
__device__ __forceinline__ void unpack8(const v4u v, float (&f)[8]) { f[0] = bflo(v.x); f[1] = bfhi(v.x); f[2] = bflo(v.y); f[3] = bfhi(v.y); f[4] = bflo(v.z); f[5] = bfhi(v.z); f[6] = bflo(v.w); f[7] = bfhi(v.w); }
__device__ __forceinline__ v4u pack8(const float (&f)[8]) { v4u v; v.x = pk2(f[0], f[1]); v.y = pk2(f[2], f[3]); v.z = pk2(f[4], f[5]); v.w = pk2(f[6], f[7]); return v; }
__device__ __forceinline__ float sigmoidf_(float x) { return 1.f / (1.f + __expf(-x)); }
__device__ __forceinline__ float wave_sum(float v) {
#pragma unroll
    for (int o = 1; o < 64; o <<= 1) v += __shfl_xor(v, o);
    return v;
}
#define XB_TMO      128
#define XB_XCNT(j)  (256  + 64 * (j))
#define XB_XSUB(j)  (1280 + 64 * (j))
#define XB_XGEN(j)  (2304 + 64 * (j))
#define XB_TOP      3328
#define XB_TOPGEN   3392
#define XCD_BAR_WORDS 3456
#define XB_SPIN_CAP (1u << 18)

__device__ __forceinline__ unsigned xb_ld(unsigned* p)              { return __hip_atomic_load(p, __ATOMIC_RELAXED, __HIP_MEMORY_SCOPE_AGENT); }
__device__ __forceinline__ unsigned xb_add(unsigned* p, unsigned v) { return __hip_atomic_fetch_add(p, v, __ATOMIC_RELAXED, __HIP_MEMORY_SCOPE_AGENT); }
__device__ __forceinline__ unsigned xb_xcc_id() { return (unsigned)__builtin_amdgcn_s_getreg((3 << 11) | 20) & 0xFu; }
#define XB_SPIN(cond, bar) do { unsigned _sp = 0; while (cond) { __builtin_amdgcn_s_sleep(1); \
    if ((++_sp & 255u) == 0u) { if (xb_ld(&(bar)[XB_TMO])) break; if (_sp > XB_SPIN_CAP) { atomicAdd(&(bar)[XB_TMO], 1u); break; } } } } while (0)

struct XcdBarrier {
    unsigned* bar; unsigned x;
    volatile LAS unsigned* st;
};

__device__ __forceinline__ XcdBarrier xcd_barrier_post(unsigned* bar, volatile LAS unsigned* st) {
    XcdBarrier b; b.bar = bar; b.x = xb_xcc_id(); b.st = st;
    if (threadIdx.x == 0) (void)xb_add(&bar[XB_XCNT(b.x)], 1u);
    return b;
}
__device__ __forceinline__ void xcd_barrier_complete(unsigned* bar, unsigned x, unsigned& nloc, unsigned& nx) {
    const unsigned G = gridDim.x * gridDim.y * gridDim.z;
    unsigned sum, cnt, mine, sp = 0u;
    for (;;) {
        sum = 0u; cnt = 0u; mine = 0u;
#pragma unroll
        for (unsigned j = 0; j < 16; ++j) { const unsigned c = xb_ld(&bar[XB_XCNT(j)]); sum += c; cnt += (c > 0u) ? 1u : 0u; mine = (j == x) ? c : mine; }
        if (sum == G) break;
        __builtin_amdgcn_s_sleep(1);
        if ((++sp & 255u) == 0u) { if (xb_ld(&bar[XB_TMO])) break; if (sp > XB_SPIN_CAP) { atomicAdd(&bar[XB_TMO], 1u); break; } }
    }
    nloc = mine > 0u ? mine : 1u; nx = cnt > 0u ? cnt : 1u;
}

__device__ __forceinline__ void xcd_barrier(const XcdBarrier& b) {
    asm volatile("s_waitcnt vmcnt(0)" ::: "memory");
    __syncthreads();
    if (threadIdx.x == 0) {
        unsigned* bar = b.bar;
        __builtin_amdgcn_s_waitcnt(0);
        unsigned nloc = b.st[0], nx = b.st[1];
        if (nloc == 0u) { xcd_barrier_complete(bar, b.x, nloc, nx); b.st[0] = nloc; b.st[1] = nx; }
        const unsigned old = xb_add(&bar[XB_XSUB(b.x)], 1u);
        const unsigned gen = old / nloc;
        if (old + 1u == (gen + 1u) * nloc) {
            __builtin_amdgcn_fence(__ATOMIC_RELEASE, "agent");
            asm volatile("s_waitcnt vmcnt(0)" ::: "memory");
            const unsigned og = xb_add(&bar[XB_TOP], 1u);
            const unsigned tg = og / nx;
            if (og + 1u == (tg + 1u) * nx) xb_add(&bar[XB_TOPGEN], 1u);
            else XB_SPIN(xb_ld(&bar[XB_TOPGEN]) == tg, bar);
            __builtin_amdgcn_fence(__ATOMIC_ACQUIRE, "agent");
            xb_add(&bar[XB_XGEN(b.x)], 1u);
            asm volatile("s_waitcnt vmcnt(0)" ::: "memory");
        } else {
            XB_SPIN(xb_ld(&bar[XB_XGEN(b.x)]) == gen, bar);
            __builtin_amdgcn_fence(__ATOMIC_ACQUIRE, "agent");
            asm volatile("s_waitcnt vmcnt(0)" ::: "memory");
        }
    }
    __syncthreads();
}

struct Frame {
    LAS unsigned char* lds;
    int tid, lane, wave, vcu, G;
    const unsigned char* ka;
    unsigned char* ws; float* out;
    __device__ __forceinline__ Frame fresh() const { Frame G_ = *this; int l_ = lane; asm volatile("" : "+v"(l_)); G_.lane = l_; G_.tid = wave * 64 + l_; return G_; }
    __device__ __forceinline__ const float* in(int i) const { const unsigned char* k = ka; asm volatile("" : "+s"(k)); return *(const float* const*)(k + 8 * i); }
#define FIN(name, idx) __device__ __forceinline__ const float* name() const { return in(idx); }
    FIN(x, 0) FIN(w_in, 1) FIN(w_out, 2) FIN(norm_mix, 3) FIN(norm_mlp, 4) FIN(conv_w, 5) FIN(conv_b, 6) FIN(lru_wa, 7) FIN(lru_ba, 8) FIN(lru_wx, 9) FIN(lru_bx, 10) FIN(lru_lam, 11)
    FIN(hg_lb, 12) FIN(hg_nw, 13) FIN(lru_on, 14) FIN(att_on, 15) FIN(w_ff1, 16) FIN(w_ff2, 17) FIN(norm_final, 18)
#undef FIN
#define FWS(type, name, off) __device__ __forceinline__ type* name() const { return (type*)(ws + (off)); }
    FWS(float, SSQ, WS_SSQ) FWS(float, KMP, WS_KMP) FWS(unsigned, SEL, WS_SEL) FWS(float, LRUA, WS_LRUA) FWS(float, LRUU, WS_LRUU) FWS(float, LRUC, WS_LRUC) FWS(float, HGD, WS_HGD) FWS(float, HGS, WS_HGS)
    FWS(float, LB, WS_LB) FWS(float, SP, WS_SP) FWS(bf16, GW, WS_GW) FWS(bf16, WIN, WS_WIN) FWS(bf16, WOUT, WS_WOUT) FWS(bf16, W1, WS_W1) FWS(bf16, W2, WS_W2) FWS(bf16, XB, WS_XB) FWS(bf16, Z, WS_Z) FWS(bf16, Y, WS_Y) FWS(bf16, H, WS_H)
#undef FWS
};

__device__ __forceinline__ float gain_of(const float* g0, const float* g1, int mode, int k) {
    if (mode == 1 || mode == 2) return g0[k];
    if (mode == 3) return k < 256 ? g0[k] : (k < 512 ? 1.f : g1[k - 512]);
    return 1.f;
}
__device__ __forceinline__ void p0_transpose_item(const Frame& F, const float* W, int K, int N, bf16* WT, LAS float* scr, int item, int lane, int mode, int l) {
    const float* g0 = mode == 1 ? F.norm_mix() + l * DM : (mode == 2 ? F.norm_mlp() + l * DM : F.lru_on() + l * 256); const float* g1 = F.att_on() + l * 512;
    const int nblk = N / 32, kb = item / nblk, nb = item % nblk, k0 = 64 * kb, n0 = 32 * nb;
    float wv[32];
#pragma unroll
    for (int i = 0; i < 32; ++i) { const int kk = 2 * i + (lane >> 5); wv[i] = W[(size_t)(k0 + kk) * N + n0 + (lane & 31)]; }
#pragma unroll
    for (int i = 0; i < 32; ++i) { const int kk = 2 * i + (lane >> 5); scr[kk * 33 + (lane & 31)] = wv[i] * gain_of(g0, g1, mode, k0 + kk); }
    asm volatile("s_waitcnt lgkmcnt(0)" ::: "memory");
    const int c = lane & 7;
#pragma unroll
    for (int j = 0; j < 4; ++j) { const int n = (lane >> 3) + 8 * j; const LAS float* s = scr + (8 * c) * 33 + n;
        v4u o; o.x = pk2(s[0 * 33], s[1 * 33]); o.y = pk2(s[2 * 33], s[3 * 33]); o.z = pk2(s[4 * 33], s[5 * 33]); o.w = pk2(s[6 * 33], s[7 * 33]);
        *(GAS v4u*)(WT + (size_t)(n0 + n) * K + k0 + 8 * c) = o; }
    asm volatile("s_waitcnt lgkmcnt(0)" ::: "memory");
}
__device__ __forceinline__ void p0_prologue(const Frame& F) {
    LAS float* scr = (LAS float*)(F.lds + F.wave * 16384);
    const int gw = F.vcu * NWAVES + F.wave, NGW = F.G * NWAVES;
    constexpr int I_IN = (DM / 64) * (DIN / 32), I_OUT = (DM / 64) * (DM / 32), I_1 = (DM / 64) * (FF / 32), I_2 = (FF / 64) * (DM / 32);
    constexpr int PER_L = I_IN + I_OUT + I_1 + I_2;
    for (int it = gw; it < DEPTH * PER_L; it += NGW) {
        const int l = it / PER_L; int r = it % PER_L;
        if (r < I_IN) { p0_transpose_item(F, F.w_in() + (size_t)l * DM * DIN, DM, DIN, F.WIN() + (size_t)l * DIN * DM, scr, r, F.lane, 1, l); continue; } r -= I_IN;
        if (r < I_OUT) { p0_transpose_item(F, F.w_out() + (size_t)l * DM * DM, DM, DM, F.WOUT() + (size_t)l * DM * DM, scr, r, F.lane, 3, l); continue; } r -= I_OUT;
        if (r < I_1) { p0_transpose_item(F, F.w_ff1() + (size_t)l * DM * FF, DM, FF, F.W1() + (size_t)l * FF * DM, scr, r, F.lane, 2, l); continue; } r -= I_1;
        p0_transpose_item(F, F.w_ff2() + (size_t)l * FF * DM, FF, DM, F.W2() + (size_t)l * DM * FF, scr, r, F.lane, 0, l);
    }
    for (int m = gw; m < M; m += NGW) {
        const GAS f32x4* xr = (const GAS f32x4*)(F.x() + (size_t)m * DM) + F.lane; f32x4 v[4]; float s = 0.f;
#pragma unroll
        for (int j = 0; j < 4; ++j) { v[j] = xr[64 * j]; s += (v[j].x * v[j].x + v[j].y * v[j].y) + (v[j].z * v[j].z + v[j].w * v[j].w); }
        s = wave_sum(s);
        GAS unsigned long long* o8 = (GAS unsigned long long*)(F.XB() + (size_t)m * DM) + F.lane;
#pragma unroll
        for (int j = 0; j < 4; ++j) o8[64 * j] = (unsigned long long)pk2(v[j].x, v[j].y) | ((unsigned long long)pk2(v[j].z, v[j].w) << 32);
        if (F.lane == 0) *(f32x4*)(F.SSQ() + (size_t)m * 4) = (f32x4){s, 0.f, 0.f, 0.f};
    }
    const int gt = F.vcu * 512 + F.tid, NGT = F.G * 512;
    for (int e = gt; e < DEPTH * 2 * 4 * 64 * 64; e += NGT) {
        const int i = e & 63, j = (e >> 6) & 63, g = (e >> 12) & 3, mat = (e >> 14) & 1, l = e >> 15;
        const float* w = mat ? F.lru_wx() : F.lru_wa();
        F.GW()[e] = (bf16)f2bf(w[((size_t)(l * 4 + g) * 64 + i) * 64 + j]);
    }
    for (int e = gt; e < DEPTH * 256; e += NGT) {
        const int l = e >> 8, c = e & 255;
        const float h0 = F.hg_lb()[c], h1 = F.hg_lb()[256 + c], mx = fmaxf(h0, h1), e0 = expf(h0 - mx), e1 = expf(h1 - mx);
        F.LB()[e] = l == 0 ? 0.f : e1 / (e0 + e1);
        const float lam = F.lru_lam()[e]; F.SP()[e] = fmaxf(-lam, 0.f) + log1pf(expf(-fabsf(lam)));
    }
}

constexpr int HB = 72;
constexpr int HS = 68, HS1 = 65;
__device__ __forceinline__ int crow(int r, int hi) { return (r & 3) + 8 * (r >> 2) + 4 * hi; }
__device__ __forceinline__ float fast_sigmoid(float x) { return __builtin_amdgcn_rcpf(1.f + __expf(-x)); }
__device__ __forceinline__ void hg_unit(const Frame& F0, int l, int unit, bool fin) {
    const Frame F = F0.fresh();
    const int tid = F.tid, lane = F.lane, wid = F.wave, r32 = lane & 31, hi = lane >> 5;
    const int c = unit & 127, bh = unit >> 7, h = bh & 3, b = bh >> 2;
    const size_t row0 = (size_t)b * T + (size_t)c * 64;
    LAS float* Lb = (LAS float*)F.lds; LAS float* Lx = Lb + 64 * HS1; LAS float* Lo = Lx + 512;
    LAS bf16* Qt = (LAS bf16*)(Lo + 64 * HS); LAS bf16* K0 = Qt + 64 * HB; LAS bf16* K1 = K0 + 32 * HB; LAS bf16* Qe = K1 + 64 * HB;
    LAS bf16* VT = Qe + 64 * HB; LAS bf16* KdT = VT + 64 * HB; LAS bf16* ST = KdT + 64 * HB; LAS bf16* At = ST + 64 * HB;
    const int r = tid >> 3, c8 = (tid & 7) * 8;
    __syncthreads();
    float qs[8], kk[8];
    {
        const bf16* zr = F.Z() + (row0 + r) * DIN + h * 64 + c8;
        float q[8], f[8], v[8];
        unpack8(*(const v4u*)(zr + Z_BQ), q); unpack8(*(const v4u*)(zr + Z_BF), f); unpack8(*(const v4u*)(zr + Z_BI), v);
        const f32x4 lb0 = *(const f32x4*)(F.LB() + l * 256 + h * 64 + c8), lb1 = *(const f32x4*)(F.LB() + l * 256 + h * 64 + c8 + 4);
#pragma unroll
        for (int j = 0; j < 8; ++j) {
            const float lb = j < 4 ? lb0[j & 3] : lb1[j & 3];
            const float e = __expf(-f[j]), rr = __builtin_amdgcn_rcpf(1.f + e);
            const float fg = lb + (1.f - lb) * rr;
            Lb[r * HS1 + c8 + j] = __logf(fmaxf(fg, 1e-37f));
            kk[j] = (1.f - lb) * (e * rr);
            qs[j] = q[j] * fast_sigmoid(q[j]);
            VT[(c8 + j) * HB + r] = (bf16)f2bf(v[j]);
        }
    }
    f32x4 s0 = {0.f, 0.f, 0.f, 0.f}, s1 = {0.f, 0.f, 0.f, 0.f};
    if (fin) { const float* hp = F.HGS() + (size_t)unit * 4096 + r * 64 + c8; s0 = *(const f32x4*)hp; s1 = *(const f32x4*)(hp + 4); }
    __syncthreads();
    {
        const int d = tid & 63, sg = tid >> 6; float run = 0.f;
#pragma unroll
        for (int i = 0; i < 8; ++i) { run += Lb[(sg * 8 + i) * HS1 + d]; Lb[(sg * 8 + i) * HS1 + d] = run; }
        Lx[sg * 64 + d] = run;
        __syncthreads();
        float pre = 0.f;
        for (int s2 = 0; s2 < sg; ++s2) pre += Lx[s2 * 64 + d];
#pragma unroll
        for (int i = 0; i < 8; ++i) Lb[(sg * 8 + i) * HS1 + d] += pre;
    }
    __syncthreads();
    if (!fin) {
#pragma unroll
        for (int j = 0; j < 8; ++j) KdT[(c8 + j) * HB + r] = (bf16)f2bf(kk[j] * __expf(Lb[63 * HS1 + c8 + j] - Lb[r * HS1 + c8 + j]));
        __syncthreads();
        if (wid < 4) {
            const int et = wid >> 1, dt = wid & 1; f32x16 acc;
#pragma unroll
            for (int q_ = 0; q_ < 16; ++q_) acc[q_] = 0.f;
#pragma unroll
            for (int ks = 0; ks < 4; ++ks) { const bf16x8 a = *(const LAS bf16x8*)(VT + (et * 32 + r32) * HB + ks * 16 + hi * 8), bb = *(const LAS bf16x8*)(KdT + (dt * 32 + r32) * HB + ks * 16 + hi * 8);
                acc = __builtin_amdgcn_mfma_f32_32x32x16_bf16(a, bb, acc, 0, 0, 0); }
            float* hp = F.HGS() + (size_t)unit * 4096 + dt * 32 + r32;
#pragma unroll
            for (int q_ = 0; q_ < 16; ++q_) hp[(et * 32 + crow(q_, hi)) * 64] = acc[q_];
        } else if (wid == 4) F.HGD()[unit * 64 + lane] = __expf(Lb[63 * HS1 + lane]);
        return;
    }
    {
        float qt[8], qe[8], k1[8], k0[8];
#pragma unroll
        for (int j = 0; j < 8; ++j) { const float bt = Lb[r * HS1 + c8 + j], b31 = Lb[31 * HS1 + c8 + j], rho = r < 32 ? 0.f : b31;
            qt[j] = qs[j] * __expf(bt - rho); qe[j] = qs[j] * __expf(bt); k1[j] = kk[j] * __expf(fminf(b31 - bt, 80.f)); k0[j] = kk[j] * __expf(fminf(-bt, 80.f)); }
        *(LAS v4u*)(Qt + r * HB + c8) = pack8(qt); *(LAS v4u*)(Qe + r * HB + c8) = pack8(qe); *(LAS v4u*)(K1 + r * HB + c8) = pack8(k1);
        if (r < 32) *(LAS v4u*)(K0 + r * HB + c8) = pack8(k0);
        float sv[8] = {s0[0], s0[1], s0[2], s0[3], s1[0], s1[1], s1[2], s1[3]};
        *(LAS v4u*)(ST + r * HB + c8) = pack8(sv);
    }
    __syncthreads();
    if (wid < 3) {
        const int tb = wid == 0 ? 0 : 32, sb = wid == 2 ? 32 : 0; const LAS bf16* Kp = wid == 0 ? K0 : K1; f32x16 acc;
#pragma unroll
        for (int q_ = 0; q_ < 16; ++q_) acc[q_] = 0.f;
#pragma unroll
        for (int ks = 0; ks < 4; ++ks) { const bf16x8 a = *(const LAS bf16x8*)(Qt + (tb + r32) * HB + ks * 16 + hi * 8), bb = *(const LAS bf16x8*)(Kp + (sb + r32) * HB + ks * 16 + hi * 8);
            acc = __builtin_amdgcn_mfma_f32_32x32x16_bf16(a, bb, acc, 0, 0, 0); }
#pragma unroll
        for (int q_ = 0; q_ < 16; ++q_) { const int tl = crow(q_, hi); const float val = (wid == 1 || r32 <= tl) ? acc[q_] : 0.f; At[(tb + tl) * HB + sb + r32] = (bf16)f2bf(val); }
    }
    __syncthreads();
    if (wid < 4) {
        const int tt = wid >> 1, et = wid & 1; f32x16 acc;
#pragma unroll
        for (int q_ = 0; q_ < 16; ++q_) acc[q_] = 0.f;
#pragma unroll
        for (int ks = 0; ks < 4; ++ks) if (ks < 2 || tt == 1) { const bf16x8 a = *(const LAS bf16x8*)(At + (tt * 32 + r32) * HB + ks * 16 + hi * 8), bb = *(const LAS bf16x8*)(VT + (et * 32 + r32) * HB + ks * 16 + hi * 8);
            acc = __builtin_amdgcn_mfma_f32_32x32x16_bf16(a, bb, acc, 0, 0, 0); }
#pragma unroll
        for (int ks = 0; ks < 4; ++ks) { const bf16x8 a = *(const LAS bf16x8*)(Qe + (tt * 32 + r32) * HB + ks * 16 + hi * 8), bb = *(const LAS bf16x8*)(ST + (et * 32 + r32) * HB + ks * 16 + hi * 8);
            acc = __builtin_amdgcn_mfma_f32_32x32x16_bf16(a, bb, acc, 0, 0, 0); }
#pragma unroll
        for (int q_ = 0; q_ < 16; ++q_) Lo[(tt * 32 + crow(q_, hi)) * HS + et * 32 + r32] = acc[q_];
    }
    __syncthreads();
    {
        const int t = r, e8 = c8; const f32x4 a0 = *(const LAS f32x4*)(Lo + t * HS + e8), a1 = *(const LAS f32x4*)(Lo + t * HS + e8 + 4);
        float acc[8] = {a0[0], a0[1], a0[2], a0[3], a1[0], a1[1], a1[2], a1[3]}; float ss = 0.f;
#pragma unroll
        for (int j = 0; j < 8; ++j) ss += acc[j] * acc[j];
        ss += __shfl_xor(ss, 1); ss += __shfl_xor(ss, 2); ss += __shfl_xor(ss, 4);
        const float rs = rsqrtf(ss * (1.f / 64.f) + EPS);
        float g[8]; unpack8(*(const v4u*)(F.Z() + (row0 + t) * DIN + Z_BG + h * 64 + e8), g);
        const float* nw = F.hg_nw() + l * 64 + e8;
        float o[8];
#pragma unroll
        for (int j = 0; j < 8; ++j) o[j] = acc[j] * rs * nw[j] * (g[j] * fast_sigmoid(g[j]));
        *(v4u*)(F.Y() + (row0 + t) * DM + Y_B + h * 64 + e8) = pack8(o);
    }
}

constexpr int XS = 264;
__device__ __forceinline__ float gelu_tanh(float x) { const float u = 0.7978845608028654f * (x + 0.044715f * x * x * x); return x * __builtin_amdgcn_rcpf(1.f + __expf(-2.f * u)); }
__device__ __forceinline__ void lru_unit(const Frame& F0, int l, int unit, bool fin) {
    const Frame F = F0.fresh();
    const int tid = F.tid, lane = F.lane, wid = F.wave;
    const int c32 = unit & 255, b = unit >> 8, t0 = c32 * 32; const size_t row0 = (size_t)b * T + t0;
    LAS bf16* Lx = (LAS bf16*)F.lds; LAS float* La = (LAS float*)(F.lds + 32 * XS * 2); LAS float* Lu = La + 32 * 256; LAS bf16* Lr = (LAS bf16*)(Lu + 32 * 256);
    const int g = wid >> 1, half = wid & 1, r32 = lane & 31, hi = lane >> 5, chl = half * 32 + r32, ch = g * 64 + chl;
    const int r = tid >> 4, cg = (tid & 15) * 16;
    __syncthreads();
    v4u raw[3];
#pragma unroll
    for (int i = 0; i < 3; ++i) { const int p = tid + i * 512, rr = p >> 5, pc = p & 31, t = t0 - 3 + rr; raw[i] = (v4u){0u, 0u, 0u, 0u};
        if (p < 35 * 32 && t >= 0) raw[i] = *(const v4u*)(F.Z() + ((size_t)b * T + t) * DIN + Z_AX + pc * 8); }
    bf16x8 ba[4], bx[4];
    { const bf16* gwa = F.GW() + ((size_t)((l * 2 + 0) * 4 + g) * 64 + chl) * 64; const bf16* gwx = F.GW() + ((size_t)((l * 2 + 1) * 4 + g) * 64 + chl) * 64;
#pragma unroll
      for (int ks = 0; ks < 4; ++ks) { ba[ks] = *(const bf16x8*)(gwa + ks * 16 + hi * 8); bx[ks] = *(const bf16x8*)(gwx + ks * 16 + hi * 8); } }
    const float bav = F.lru_ba()[l * 256 + ch], bxv = F.lru_bx()[l * 256 + ch], spv = F.SP()[l * 256 + ch];
    LAS float* Lw = (LAS float*)(Lr + 35 * XS);
    float wreg[3];
#pragma unroll
    for (int i = 0; i < 3; ++i) { const int p = tid + i * 512; wreg[i] = 0.f; if (p < 1024) wreg[i] = F.conv_w()[(size_t)l * 1024 + p]; else if (p < 1280) wreg[i] = F.conv_b()[l * 256 + p - 1024]; }
    float cy = 0.f; v4u gy0 = {0u, 0u, 0u, 0u}, gy1 = {0u, 0u, 0u, 0u};
    if (fin) { if (tid < 256) cy = F.LRUC()[unit * 256 + tid]; const bf16* zr = F.Z() + (row0 + r) * DIN + Z_AY + cg; gy0 = *(const v4u*)zr; gy1 = *(const v4u*)(zr + 8); }
#pragma unroll
    for (int i = 0; i < 3; ++i) { const int p = tid + i * 512, rr = p >> 5, pc = p & 31; if (p < 35 * 32) *(LAS v4u*)(Lr + rr * XS + pc * 8) = raw[i]; if (p < 1280) Lw[p] = wreg[i]; }
    __syncthreads();
    {
        float acc[16];
#pragma unroll
        for (int j = 0; j < 16; j += 4) { const f32x4 t4 = *(const LAS f32x4*)(Lw + 1024 + cg + j); acc[j] = t4[0]; acc[j + 1] = t4[1]; acc[j + 2] = t4[2]; acc[j + 3] = t4[3]; }
#pragma unroll
        for (int k = 0; k < 4; ++k) { float x0[8], x1[8]; unpack8(*(const LAS v4u*)(Lr + (r + k) * XS + cg), x0); unpack8(*(const LAS v4u*)(Lr + (r + k) * XS + cg + 8), x1);
#pragma unroll
            for (int j = 0; j < 8; j += 4) { const f32x4 w0 = *(const LAS f32x4*)(Lw + k * 256 + cg + j), w1 = *(const LAS f32x4*)(Lw + k * 256 + cg + 8 + j);
#pragma unroll
                for (int e = 0; e < 4; ++e) { acc[j + e] += w0[e] * x0[j + e]; acc[8 + j + e] += w1[e] * x1[j + e]; } } }
        float a0[8], a1[8];
#pragma unroll
        for (int j = 0; j < 8; ++j) { a0[j] = acc[j]; a1[j] = acc[8 + j]; }
        *(LAS v4u*)(Lx + r * XS + cg) = pack8(a0); *(LAS v4u*)(Lx + r * XS + cg + 8) = pack8(a1);
    }
    __syncthreads();
    {
        f32x16 racc, iacc;
#pragma unroll
        for (int q_ = 0; q_ < 16; ++q_) { racc[q_] = 0.f; iacc[q_] = 0.f; }
#pragma unroll
        for (int ks = 0; ks < 4; ++ks) {
            const bf16x8 a = *(const LAS bf16x8*)(Lx + r32 * XS + g * 64 + ks * 16 + hi * 8);
            racc = __builtin_amdgcn_mfma_f32_32x32x16_bf16(a, ba[ks], racc, 0, 0, 0); iacc = __builtin_amdgcn_mfma_f32_32x32x16_bf16(a, bx[ks], iacc, 0, 0, 0);
        }
#pragma unroll
        for (int q_ = 0; q_ < 16; ++q_) { const int tok = crow(q_, hi);
            const float xcv = bf1(Lx[tok * XS + ch]);
            const float rg = fast_sigmoid(racc[q_] + bav), ig = fast_sigmoid(iacc[q_] + bxv);
            const float la = -8.f * rg * spv, av = __expf(la), x2 = 2.f * la;
            const float em = x2 > -0.3f ? -x2 * (1.f + x2 * 0.5f * (1.f + x2 * (1.f / 3.f) * (1.f + x2 * 0.25f * (1.f + x2 * 0.2f)))) : 1.f - __expf(x2);
            La[tok * 256 + ch] = av; Lu[tok * 256 + ch] = sqrtf(em) * ig * xcv; }
    }
    __syncthreads();
    if (tid < 256) {
        float hc = cy, P = 1.f;
#pragma unroll 8
        for (int t = 0; t < 32; ++t) { const float av = La[t * 256 + tid], uv = Lu[t * 256 + tid]; hc = av * hc + uv; P *= av; if (fin) Lu[t * 256 + tid] = hc; }
        if (!fin) { F.LRUA()[unit * 256 + tid] = P; F.LRUU()[unit * 256 + tid] = hc; }
    }
    if (!fin) return;
    __syncthreads();
    {
        float g0[8], g1[8]; unpack8(gy0, g0); unpack8(gy1, g1);
        float v0[8], v1[8], ss = 0.f;
#pragma unroll
        for (int j = 0; j < 8; ++j) { v0[j] = Lu[r * 256 + cg + j] * gelu_tanh(g0[j]); v1[j] = Lu[r * 256 + cg + 8 + j] * gelu_tanh(g1[j]); ss += v0[j] * v0[j] + v1[j] * v1[j]; }
        ss += __shfl_xor(ss, 1); ss += __shfl_xor(ss, 2); ss += __shfl_xor(ss, 4); ss += __shfl_xor(ss, 8);
        const float rs = rsqrtf(ss * (1.f / 256.f) + EPS);
#pragma unroll
        for (int j = 0; j < 8; ++j) { v0[j] *= rs; v1[j] *= rs; }
        bf16* yr = F.Y() + (row0 + r) * DM + Y_A + cg; *(v4u*)yr = pack8(v0); *(v4u*)(yr + 8) = pack8(v1);
    }
}

__device__ __forceinline__ void kmean_unit(const Frame& F0, int unit) {
    const Frame F = F0.fresh();
    const int q = unit & 3, n = (unit >> 2) & 31, b = unit >> 7, rg = F.tid >> 6, ch = F.tid & 63;
    LAS float* part = (LAS float*)F.lds;
    __syncthreads();
    const bf16* zp = F.Z() + ((size_t)b * T + (size_t)n * 256 + q * 64 + rg * 8) * DIN + Z_CK + ch * 8; float s[8];
#pragma unroll
    for (int j = 0; j < 8; ++j) s[j] = 0.f;
#pragma unroll
    for (int r = 0; r < 8; ++r) { float t8[8]; unpack8(*(const v4u*)(zp + (size_t)r * DIN), t8);
#pragma unroll
        for (int j = 0; j < 8; ++j) s[j] += t8[j]; }
    *(LAS f32x4*)(part + rg * 512 + ch * 8) = (f32x4){s[0], s[1], s[2], s[3]}; *(LAS f32x4*)(part + rg * 512 + ch * 8 + 4) = (f32x4){s[4], s[5], s[6], s[7]};
    __syncthreads();
    float t = 0.f;
#pragma unroll
    for (int g = 0; g < 8; ++g) t += part[g * 512 + F.tid];
    F.KMP()[(size_t)unit * 512 + F.tid] = t;
}
__device__ __forceinline__ void select_unit(const Frame& F0, int item) {
    const Frame F = F0.fresh();
    const int hp = item & 3, j = (item >> 2) & 31, b = item >> 7, hsel = F.tid >> 8, h = hp * 2 + hsel, tok = F.tid & 255;
    LAS float* km = (LAS float*)F.lds;
    __syncthreads();
#pragma unroll
    for (int i = 0; i < 8; ++i) { const int e = i * 512 + F.tid, hs = e >> 11, n = (e >> 6) & 31, dd = e & 63; const float* kp = F.KMP() + ((size_t)(b * 32 + n) * 4) * 512 + (hp * 2 + hs) * 64 + dd;
        km[e] = ((kp[0] + kp[512]) + (kp[1024] + kp[1536])) * (1.f / 256.f); }
    __syncthreads();
    const size_t row = (size_t)b * T + (size_t)j * 256 + tok;
    float q[64];
#pragma unroll
    for (int i = 0; i < 8; ++i) { float t8[8]; unpack8(*(const v4u*)(F.Z() + row * DIN + Z_CQ + h * 64 + i * 8), t8);
#pragma unroll
        for (int e = 0; e < 8; ++e) q[i * 8 + e] = t8[e]; }
    float v1 = -INFINITY, v2 = -INFINITY, v3 = -INFINITY; int i1 = -1, i2 = -1, i3 = -1;
    for (int n = 0; n < j; ++n) { const LAS float* kp = km + (hsel * 32 + n) * 64; float g = 0.f;
#pragma unroll
        for (int d = 0; d < 64; d += 4) { const f32x4 kv = *(const LAS f32x4*)(kp + d); g += q[d] * kv[0] + q[d + 1] * kv[1] + q[d + 2] * kv[2] + q[d + 3] * kv[3]; }
        if (g > v1) { v3 = v2; i3 = i2; v2 = v1; i2 = i1; v1 = g; i1 = n; }
        else if (g > v2) { v3 = v2; i3 = i2; v2 = g; i2 = n; }
        else if (g > v3) { v3 = g; i3 = n; } }
    unsigned msk = 0u; if (i1 >= 0) msk |= 1u << i1; if (i2 >= 0) msk |= 1u << i2; if (i3 >= 0) msk |= 1u << i3;
    F.SEL()[row * 8 + h] = msk;
}

__device__ __forceinline__ void hg_scan_item(const Frame& F0, int item) {
    const Frame F = F0.fresh();
    const int el = F.tid & 63, grp = F.tid >> 6, e = item * 64 + el, seq = e >> 12, de = e & 4095, dd = de & 63;
    LAS float* gS = (LAS float*)F.lds; LAS float* gD = gS + 512;
    __syncthreads();
    float Hc[16], Dc[16]; float* hp = F.HGS() + (size_t)(seq * 128 + grp * 16) * 4096 + de; const float* dp = F.HGD() + (seq * 128 + grp * 16) * 64 + dd;
#pragma unroll
    for (int i = 0; i < 16; ++i) { Hc[i] = hp[(size_t)i * 4096]; Dc[i] = dp[i * 64]; }
    float s = 0.f, pd = 1.f;
#pragma unroll
    for (int i = 0; i < 16; ++i) { s = Dc[i] * s + Hc[i]; pd *= Dc[i]; }
    gS[grp * 64 + el] = s; gD[grp * 64 + el] = pd;
    __syncthreads();
    float cy = 0.f;
    for (int g = 0; g < grp; ++g) cy = gD[g * 64 + el] * cy + gS[g * 64 + el];
#pragma unroll
    for (int i = 0; i < 16; ++i) { hp[(size_t)i * 4096] = cy; cy = Dc[i] * cy + Hc[i]; }
}
__device__ __forceinline__ void lru_scan_item(const Frame& F0, int item) {
    const Frame F = F0.fresh();
    const int sl = F.tid & 31, grp = F.tid >> 5, sidx = item * 32 + sl, b = sidx >> 8, ch = sidx & 255;
    LAS float* gA = (LAS float*)F.lds; LAS float* gU = gA + 512;
    __syncthreads();
    float A[16], U[16]; const int u0 = (b * 256 + grp * 16) * 256 + ch;
#pragma unroll
    for (int i = 0; i < 16; ++i) { A[i] = F.LRUA()[u0 + i * 256]; U[i] = F.LRUU()[u0 + i * 256]; }
    float pa = 1.f, pu = 0.f;
#pragma unroll
    for (int i = 0; i < 16; ++i) { pu = A[i] * pu + U[i]; pa *= A[i]; }
    gA[grp * 32 + sl] = pa; gU[grp * 32 + sl] = pu;
    __syncthreads();
    float cy = 0.f;
    for (int g = 0; g < grp; ++g) cy = gA[g * 32 + sl] * cy + gU[g * 32 + sl];
#pragma unroll
    for (int i = 0; i < 16; ++i) { F.LRUC()[u0 + i * 256] = cy; cy = A[i] * cy + U[i]; }
}

namespace moba {
typedef LAS const char* lds_cptr;
typedef short v4i16_t __attribute__((ext_vector_type(4)));
constexpr int SLOTB = 8192, LDS_K = 0, LDS_V = 2 * SLOTB, LDS_WS = 4 * SLOTB, LDS_OST = LDS_WS + NWAVES * 256, LDS_FLAG = LDS_OST + NWAVES * 4096;
__device__ __forceinline__ void glds16(const void* gsrc, unsigned lds_dst) { unsigned keep;
    asm volatile("s_mov_b32 %0, m0\n\ts_mov_b32 m0, %2\n\ts_nop 0\n\tglobal_load_lds_dwordx4 %1, off\n\ts_mov_b32 m0, %0" : "=&s"(keep) : "v"(gsrc), "s"(lds_dst) : "memory"); }
typedef float f32x2_t __attribute__((ext_vector_type(2))); typedef __bf16 bf16x2_t __attribute__((ext_vector_type(2)));
__device__ __forceinline__ unsigned cvtpk_s(float lo, float hi) { f32x2_t v = {lo, hi}; bf16x2_t b = __builtin_convertvector(v, bf16x2_t); return __builtin_bit_cast(unsigned, b); }
#define MX3(a, b, c) __builtin_fmaxf(__builtin_fmaxf((a), (b)), (c))
__device__ __forceinline__ float rowmax(const f32x16& p0, const f32x16& p1) {
    float a = MX3(p0[0], p0[1], p1[0]), b = MX3(p0[2], p0[3], p1[1]); a = MX3(a, p1[2], p1[3]);
#pragma unroll
    for (int r = 4; r < 16; r += 4) { a = MX3(a, p0[r], p0[r + 1]); b = MX3(b, p0[r + 2], p0[r + 3]); a = MX3(a, p1[r], p1[r + 1]); b = MX3(b, p1[r + 2], p1[r + 3]); }
    float m = __builtin_fmaxf(a, b); auto rr = __builtin_amdgcn_permlane32_swap(__float_as_uint(m), __float_as_uint(m), false, false);
    return __builtin_fmaxf(__uint_as_float(rr[0]), __uint_as_float(rr[1])); }
#undef MX3
__device__ __forceinline__ void qkt(f32x16& p0, f32x16& p1, lds_cptr kb, const bf16x8* qr, const f32x16& c0) {
#pragma unroll
    for (int d0 = 0; d0 < 4; ++d0) {
        const bf16x8 b0 = *(const LAS bf16x8*)(kb + d0 * 2048), b1 = *(const LAS bf16x8*)(kb + d0 * 2048 + 512);
        if (d0 == 0) { p0 = __builtin_amdgcn_mfma_f32_32x32x16_bf16(b0, qr[0], c0, 0, 0, 0); p1 = __builtin_amdgcn_mfma_f32_32x32x16_bf16(b1, qr[0], c0, 0, 0, 0); }
        else { p0 = __builtin_amdgcn_mfma_f32_32x32x16_bf16(b0, qr[d0], p0, 0, 0, 0); p1 = __builtin_amdgcn_mfma_f32_32x32x16_bf16(b1, qr[d0], p1, 0, 0, 0); } }
}
__device__ __forceinline__ void pv(f32x16* o, int vb, bf16x8 pa0, bf16x8 pa1, bf16x8 pa2, bf16x8 pa3) {
#pragma unroll
    for (int d0 = 0; d0 < 2; ++d0) { s16x4 lo[4], hi[4];
#pragma unroll
        for (int ks = 0; ks < 4; ++ks) {
            asm volatile("ds_read_b64_tr_b16 %0,%1 offset:%c2" : "=&v"(lo[ks]) : "v"(vb), "i"(d0 * 4096 + ks * 1024) : "memory");
            asm volatile("ds_read_b64_tr_b16 %0,%1 offset:%c2" : "=&v"(hi[ks]) : "v"(vb), "i"(d0 * 4096 + ks * 1024 + 512) : "memory"); }
        asm volatile("s_waitcnt lgkmcnt(0)" ::: "memory"); __builtin_amdgcn_sched_barrier(0);
#define PK(k) (bf16x8){lo[k][0], lo[k][1], lo[k][2], lo[k][3], hi[k][0], hi[k][1], hi[k][2], hi[k][3]}
        o[d0] = __builtin_amdgcn_mfma_f32_32x32x16_bf16(pa0, PK(0), o[d0], 0, 0, 0);
        o[d0] = __builtin_amdgcn_mfma_f32_32x32x16_bf16(pa1, PK(1), o[d0], 0, 0, 0);
        o[d0] = __builtin_amdgcn_mfma_f32_32x32x16_bf16(pa2, PK(2), o[d0], 0, 0, 0);
        o[d0] = __builtin_amdgcn_mfma_f32_32x32x16_bf16(pa3, PK(3), o[d0], 0, 0, 0);
#undef PK
    }
}
__device__ __forceinline__ void attn_unit(const Frame& F, int b, int h, int jb) {
    LAS char* shm = (LAS char*)F.lds;
    const int lane = F.lane, r32 = lane & 31, hi = lane >> 5, wid = F.wave;
    const long rowbase = (long)b * T; const int q0 = jb * 256;
    const bf16* Qw = F.Z() + (rowbase + q0 + wid * 32) * DIN + Z_CQ + h * 64;
    const bf16* Kh = F.Z() + rowbase * DIN + Z_CK + h * 64; const bf16* Vh = F.Z() + rowbase * DIN + Z_CV + h * 64;
    const unsigned lds0 = (unsigned)(uintptr_t)shm;
    LAS float* wsf = (LAS float*)(shm + LDS_WS) + wid * 64;
    const bf16* ksrc = Kh + (long)lane * DIN + wid * 8;
    const bf16* vsrc = Vh + (long)(16 * (wid & 3) + (lane >> 2)) * DIN + (wid >> 2) * 32 + (lane & 3) * 8;
    const unsigned kdst = lds0 + LDS_K + wid * 1024, vdst = lds0 + LDS_V + wid * 1024;
#define DMA_K(pt, slot) glds16(ksrc + (long)(pt) * 64 * DIN, (unsigned)__builtin_amdgcn_readfirstlane(kdst + (slot)))
#define DMA_V(pt, slot) glds16(vsrc + (long)(pt) * 64 * DIN, (unsigned)__builtin_amdgcn_readfirstlane(vdst + (slot)))
    const int vb0 = (int)(lds0 + LDS_V) + ((lane >> 4) & 1) * 32 + (lane & 3) * 8 + (4 * hi + ((lane & 15) >> 2)) * 64;
    const lds_cptr kp0 = (lds_cptr)shm + LDS_K + hi * 1024 + r32 * 16;
    bf16x8 qr[4];
#pragma unroll
    for (int d0 = 0; d0 < 4; ++d0) qr[d0] = *(const bf16x8*)(Qw + (long)r32 * DIN + d0 * 16 + hi * 8);
    const int qrel = wid * 32 + r32;
    const unsigned selm = F.SEL()[(size_t)(rowbase + q0 + qrel) * 8 + h];
    unsigned wor = selm;
#pragma unroll
    for (int o_ = 1; o_ < 32; o_ <<= 1) wor |= (unsigned)__shfl_xor((int)wor, o_);
    LAS unsigned* flg = (LAS unsigned*)(shm + LDS_FLAG);
    __syncthreads();
    if (lane == 0) flg[wid] = wor;
    __syncthreads();
    unsigned rem = 0u;
#pragma unroll
    for (int w = 0; w < NWAVES; ++w) rem |= flg[w];
    rem = (unsigned)__builtin_amdgcn_readfirstlane((int)rem);
    const float beta = exp2f(-(float)(h + 1)) * LOG2E;
    float mhat = 0.f, l_reg = 0.f; f32x16 o[2];
#pragma unroll
    for (int r = 0; r < 16; ++r) { o[0][r] = 0.f; o[1][r] = 0.f; }
    int blk = jb, ti = 0, slot = 0; bool first = true;
    DMA_K(4 * blk, 0); DMA_V(4 * blk, 0);
    for (;;) {
        int nblk = blk, nti = ti + 1; bool has_next = true;
        if (nti == 4) { if (rem) { nblk = __builtin_ctz(rem); rem &= rem - 1u; nti = 0; } else has_next = false; }
        asm volatile("s_waitcnt vmcnt(0) lgkmcnt(0)\n\ts_barrier" ::: "memory");
        if (has_next) { DMA_K(4 * nblk + nti, (slot ^ 1) * SLOTB); DMA_V(4 * nblk + nti, (slot ^ 1) * SLOTB); }
        f32x16 negm;
#pragma unroll
        for (int r = 0; r < 16; ++r) negm[r] = -mhat;
        f32x16 p0, p1; qkt(p0, p1, kp0 + slot * SLOTB, qr, negm);
        const int pt = 4 * blk + ti;
        if (blk == jb) {
            const int kb = 64 * ti + 4 * hi;
#pragma unroll
            for (int r = 0; r < 16; ++r) { const int kv = kb + (r & 3) + 8 * (r >> 2); if (kv > qrel) p0[r] = -INFINITY; if (kv + 32 > qrel) p1[r] = -INFINITY; }
        } else if (!((selm >> blk) & 1u)) {
#pragma unroll
            for (int r = 0; r < 16; ++r) { p0[r] = -INFINITY; p1[r] = -INFINITY; }
        }
        const float ab = beta * (float)(64 * pt + 4 * hi - (q0 + qrel));
#pragma unroll
        for (int r = 0; r < 16; ++r) { const float cr = (float)((r & 3) + 8 * (r >> 2)); p0[r] += ab + beta * cr; p1[r] += ab + beta * (cr + 32.f); }
        const float rm = rowmax(p0, p1);
        bool resc = false;
        if (first || __any(rm > 0.f)) {
            const float dl = first ? rm : fmaxf(rm, 0.f); mhat += dl;
#pragma unroll
            for (int r = 0; r < 16; ++r) { p0[r] -= dl; p1[r] -= dl; }
            if (!first) { const float f = __builtin_amdgcn_exp2f(-dl); l_reg *= f; if (hi == 0) wsf[r32] = f; resc = true; }
        }
        if (resc) {
#pragma unroll
            for (int d_ = 0; d_ < 2; ++d_)
#pragma unroll
                for (int r = 0; r < 16; ++r) o[d_][r] *= wsf[crow(r, hi)];
        }
        float sacc = 0.f;
#pragma unroll
        for (int r = 0; r < 16; ++r) { p0[r] = __builtin_amdgcn_exp2f(p0[r]); p1[r] = __builtin_amdgcn_exp2f(p1[r]); sacc += p0[r] + p1[r]; }
        l_reg += sacc;
        v4u pw0, pw1, pw2, pw3;
#define PKW(P, B) cvtpk_s(P[B], P[B + 1])
        pw0 = (v4u){PKW(p0, 0), PKW(p0, 2), PKW(p0, 4), PKW(p0, 6)}; pw1 = (v4u){PKW(p0, 8), PKW(p0, 10), PKW(p0, 12), PKW(p0, 14)};
        pw2 = (v4u){PKW(p1, 0), PKW(p1, 2), PKW(p1, 4), PKW(p1, 6)}; pw3 = (v4u){PKW(p1, 8), PKW(p1, 10), PKW(p1, 12), PKW(p1, 14)};
#undef PKW
        __builtin_amdgcn_sched_barrier(0);
        pv(o, vb0 + slot * SLOTB, __builtin_bit_cast(bf16x8, pw0), __builtin_bit_cast(bf16x8, pw1), __builtin_bit_cast(bf16x8, pw2), __builtin_bit_cast(bf16x8, pw3));
        first = false;
        if (!has_next) break;
        blk = nblk; ti = nti; slot ^= 1;
    }
#undef DMA_K
#undef DMA_V
    { auto rr = __builtin_amdgcn_permlane32_swap(__float_as_uint(l_reg), __float_as_uint(l_reg), false, false); l_reg = __uint_as_float(rr[0]) + __uint_as_float(rr[1]); }
    if (hi == 0) wsf[32 + r32] = l_reg;
    float rli[16];
#pragma unroll
    for (int r = 0; r < 16; ++r) rli[r] = 1.f / wsf[32 + crow(r, hi)];
    LAS bf16* stg = (LAS bf16*)(shm + LDS_OST) + wid * 2048;
#pragma unroll
    for (int r = 0; r < 16; ++r) { const int orow = crow(r, hi);
#pragma unroll
        for (int d0 = 0; d0 < 2; ++d0) stg[orow * 64 + d0 * 32 + r32] = (bf16)f2bf(o[d0][r] * rli[r]); }
    bf16* Ow = F.Y() + (rowbase + q0 + wid * 32) * DM + Y_C + h * 64;
#pragma unroll
    for (int i = 0; i < 4; ++i) { const int row = i * 8 + (lane >> 3), ch = lane & 7; const v4u v = *(const LAS v4u*)(stg + row * 64 + ch * 8); *(v4u*)(Ow + (long)row * DM + ch * 8) = v; }
}

constexpr int F_K = 0, F_V = 3 * SLOTB, F_WS = 6 * SLOTB, F_OST = F_WS + NWAVES * 256, F_TAB = F_OST + NWAVES * 4096, F_FLAG = F_TAB + 256;
#define SBAR() __builtin_amdgcn_sched_barrier(0)
#define WAIT_BAR(N) asm volatile("s_waitcnt vmcnt(" #N ") lgkmcnt(0)\n\ts_barrier":::"memory")
__device__ __forceinline__ void kload8(bf16x8* kf, lds_cptr kp) {
    kf[0] = *(const LAS bf16x8*)(kp);        kf[1] = *(const LAS bf16x8*)(kp + 512);
    kf[2] = *(const LAS bf16x8*)(kp + 2048); kf[3] = *(const LAS bf16x8*)(kp + 2560);
    kf[4] = *(const LAS bf16x8*)(kp + 4096); kf[5] = *(const LAS bf16x8*)(kp + 4608);
    kf[6] = *(const LAS bf16x8*)(kp + 6144); kf[7] = *(const LAS bf16x8*)(kp + 6656);
}
__device__ __forceinline__ void kload2(bf16x8* kf, lds_cptr kp, int j) { kf[2 * j] = *(const LAS bf16x8*)(kp + j * 2048); kf[2 * j + 1] = *(const LAS bf16x8*)(kp + j * 2048 + 512); }
__device__ __forceinline__ s16x4 vtr(lds_cptr p) { return __builtin_bit_cast(s16x4, __builtin_amdgcn_ds_read_tr16_b64_v4i16((LAS v4i16_t*)p)); }
__device__ __forceinline__ void glds16s(const void* sbase, unsigned voff, unsigned lds_dst) { unsigned keep;
    asm volatile("s_mov_b32 %0, m0\n\ts_mov_b32 m0, %3\n\ts_nop 0\n\tglobal_load_lds_dwordx4 %1, %2\n\ts_mov_b32 m0, %0" : "=&s"(keep) : "v"(voff), "s"(sbase), "s"(lds_dst) : "memory"); }
template <int THRL> __device__ __forceinline__ void attn_unit_fast(const Frame& F0, int b, int h, int jb) {
    const Frame F = F0.fresh();
    LAS char* shm = (LAS char*)F.lds;
    const int lane = F.lane, r32 = lane & 31, hi = lane >> 5, wid = F.wave;
    const long rowbase = (long)b * T; const int q0 = jb * 256;
    const bf16* Qw = F.Z() + (rowbase + q0 + wid * 32) * DIN + Z_CQ + h * 64;
    const bf16* Kh = F.Z() + rowbase * DIN + Z_CK + h * 64; const bf16* Vh = F.Z() + rowbase * DIN + Z_CV + h * 64;
    const unsigned lds0 = (unsigned)(uintptr_t)shm;
    LAS float* wsf = (LAS float*)(shm + F_WS) + wid * 64;
    const unsigned koff = (unsigned)(lane * DIN + wid * 8) * 2u;
    const unsigned voff = (unsigned)((16 * (wid & 3) + (lane >> 2)) * DIN + (wid >> 2) * 32 + (lane & 3) * 8) * 2u;
    const unsigned kdst = lds0 + F_K + wid * 1024, vdst = lds0 + F_V + wid * 1024;
#define DMA_K(pt, slot) glds16s(Kh + (long)(pt) * 64 * DIN, koff, (unsigned)__builtin_amdgcn_readfirstlane(kdst + (slot)))
#define DMA_V(pt, slot) glds16s(Vh + (long)(pt) * 64 * DIN, voff, (unsigned)__builtin_amdgcn_readfirstlane(vdst + (slot)))
    const int vb0 = (int)(lds0 + F_V) + ((lane >> 4) & 1) * 32 + (lane & 3) * 8 + (4 * hi + ((lane & 15) >> 2)) * 64;
    const lds_cptr shm3 = (lds_cptr)shm; const lds_cptr kp0 = shm3 + F_K + hi * 1024 + r32 * 16; const lds_cptr vp0 = shm3 + F_V + ((lane >> 4) & 1) * 32 + (lane & 3) * 8 + (4 * hi + ((lane & 15) >> 2)) * 64;
    const int qrel = wid * 32 + r32;
    const unsigned selm = F.SEL()[(size_t)(rowbase + q0 + qrel) * 8 + h];
    unsigned wor = selm;
#pragma unroll
    for (int o_ = 1; o_ < 32; o_ <<= 1) wor |= (unsigned)__shfl_xor((int)wor, o_);
    LAS unsigned* flg = (LAS unsigned*)(shm + F_FLAG); LAS int* tab = (LAS int*)(shm + F_TAB);
    __syncthreads();
    if (lane == 0) flg[wid] = wor;
    __syncthreads();
    unsigned rem = 0u;
#pragma unroll
    for (int w = 0; w < NWAVES; ++w) rem |= flg[w];
    rem = (unsigned)__builtin_amdgcn_readfirstlane((int)rem);
    if (F.tid == 0) tab[0] = jb;
    if (F.tid >= 1 && F.tid <= 32 && ((rem >> (F.tid - 1)) & 1u)) tab[1 + __builtin_popcount(rem & ((1u << (F.tid - 1)) - 1u))] = F.tid - 1;
    __syncthreads();
    const int NT = 4 * (1 + __builtin_popcount(rem));
#define PT(t) (4 * __builtin_amdgcn_readfirstlane(tab[((t) >> 2) & 63]) + ((t) & 3))
    DMA_K(PT(0), 0); DMA_V(PT(0), 0); DMA_K(PT(1), SLOTB);
    bf16x8 qr[4];
#pragma unroll
    for (int d0 = 0; d0 < 4; ++d0) qr[d0] = *(const bf16x8*)(Qw + (long)r32 * DIN + d0 * 16 + hi * 8);
    const float beta = __uint_as_float((unsigned)__builtin_amdgcn_readfirstlane((int)__float_as_uint(exp2f(-(float)(h + 1)) * LOG2E)));
    const float qoff = (float)(4 * hi - (q0 + qrel));
    float mhat = 0.f, l_reg = 0.f; f32x16 o[2];
#pragma unroll
    for (int r = 0; r < 16; ++r) { o[0][r] = 0.f; o[1][r] = 0.f; }
#define INITC(C0, C1, t) do { const int bc_ = __builtin_amdgcn_readfirstlane(tab[((t) >> 2) & 63]); const bool on_ = (bc_ == jb) || ((selm >> bc_) & 1u); \
        const float ct_ = on_ ? __builtin_fmaf(beta, (float)(64 * (4 * bc_ + ((t) & 3))) + qoff, -mhat) : -1e30f; \
        _Pragma("unroll") for (int r = 0; r < 16; ++r) { const float cr_ = (float)((r & 3) + 8 * (r >> 2)); C0[r] = __builtin_fmaf(beta, cr_, ct_); C1[r] = __builtin_fmaf(beta, cr_ + 32.f, ct_); } } while (0)
#define CMASK(P0, P1, t) do { if ((t) < 4) { const int kb_ = 64 * (t) + 4 * hi; \
        _Pragma("unroll") for (int r = 0; r < 16; ++r) { const int kv_ = kb_ + (r & 3) + 8 * (r >> 2); if (kv_ > qrel) P0[r] = -INFINITY; if (kv_ + 32 > qrel) P1[r] = -INFINITY; } } } while (0)
    bool resc = false;
#define RESC() do { if (resc) { asm volatile("s_waitcnt lgkmcnt(0)" ::: "memory"); \
        _Pragma("unroll") for (int d_ = 0; d_ < 2; ++d_) _Pragma("unroll") for (int r = 0; r < 16; ++r) o[d_][r] *= wsf[crow(r, hi)]; } } while (0)
    f32x16 pA0, pA1, pB0, pB1;
    int sl_prev = 0, sl_cur = 0, sl_next = SLOTB;
#define ROT() do { sl_prev = sl_cur; sl_cur = sl_next; sl_next = (sl_next == 2 * SLOTB) ? 0 : sl_next + SLOTB; } while (0)
    DMA_K(PT(2), 2 * SLOTB);
    WAIT_BAR(3);
    INITC(pA0, pA1, 0);
    { f32x16 c0 = pA0, c1 = pA1;
#pragma unroll
      for (int d0 = 0; d0 < 4; ++d0) { const bf16x8 b0 = *(const LAS bf16x8*)(kp0 + d0 * 2048), b1 = *(const LAS bf16x8*)(kp0 + d0 * 2048 + 512);
          c0 = __builtin_amdgcn_mfma_f32_32x32x16_bf16(b0, qr[d0], c0, 0, 0, 0); c1 = __builtin_amdgcn_mfma_f32_32x32x16_bf16(b1, qr[d0], c1, 0, 0, 0); }
      pA0 = c0; pA1 = c1; }
    CMASK(pA0, pA1, 0);
    { const float dl = rowmax(pA0, pA1); mhat += dl;
#pragma unroll
      for (int r = 0; r < 16; ++r) { pA0[r] = __builtin_amdgcn_exp2f(pA0[r] - dl); pA1[r] = __builtin_amdgcn_exp2f(pA1[r] - dl); } }
    WAIT_BAR(0);
    DMA_K(PT(3), 0); DMA_V(PT(1), SLOTB);
    ROT();
    bf16x8 kf[8];
    kload8(kf, kp0 + sl_cur);
    WAIT_BAR(2);
  s16x4 vlo[8],vhi[8]; v4u pw0,pw1,pw2,pw3;
  #define PKW(P,B) cvtpk_s(P[B],P[B+1])
  #define PAF(k) __builtin_bit_cast(bf16x8,pw##k)
  #define VFR(i) (bf16x8){vlo[i][0],vlo[i][1],vlo[i][2],vlo[i][3],vhi[i][0],vhi[i][1],vhi[i][2],vhi[i][3]}
  #define PIN(x) asm volatile("":"+v"(x))
  #define MX3(a,b,c) __builtin_fmaxf(__builtin_fmaxf((a),(b)),(c))
  #define GAPA(MF,A0,A1,A2,A3,W0,W1,PW) do{ MF; sacc+=A0; sacc+=A1; sacc+=A2; sacc+=A3; PIN(sacc); W0; W1; PIN(PW); SBAR(); }while(0)
  #define EX(v) __builtin_amdgcn_exp2f(v)
  #define GAPB(MF,X,B) do{ MF; X[B]=EX(X[B]); X[B+1]=EX(X[B+1]); X[B+2]=EX(X[B+2]); X[B+3]=EX(X[B+3]); PIN(X); SBAR(); }while(0)
  #define VRD(i) do{ vlo[i]=vtr(vp_+(((i)>>2)*4096+((i)&3)*1024)); vhi[i]=vtr(vp_+(((i)>>2)*4096+((i)&3)*1024+512)); }while(0)
  #define KRD(G,j) do{ if(G){ kload2(kf,kp0+sl_next,j); SBAR(); } }while(0)
  #define STEP(C0,C1,P0,P1,t,GK,GV,GL) do{ INITC(C0,C1,t); SBAR(); \
    const lds_cptr vp_=vp0+sl_prev; \
    VRD(0); SBAR(); float sacc=(P0[0]+P0[1]); \
    GAPA(C0=__builtin_amdgcn_mfma_f32_32x32x16_bf16(kf[0],qr[0],C0,0,0,0), P0[2],P0[3],P0[4],P0[5],     pw0[0]=PKW(P0,0), pw0[1]=PKW(P0,2), pw0); \
    VRD(4); SBAR(); GAPA(C1=__builtin_amdgcn_mfma_f32_32x32x16_bf16(kf[1],qr[0],C1,0,0,0), P0[6],P0[7],P0[8],P0[9],     pw0[2]=PKW(P0,4), pw0[3]=PKW(P0,6), pw0); \
    VRD(1); SBAR(); GAPA(C0=__builtin_amdgcn_mfma_f32_32x32x16_bf16(kf[2],qr[1],C0,0,0,0),   P0[10],P0[11],P0[12],P0[13], pw1[0]=PKW(P0,8), pw1[1]=PKW(P0,10), pw1); \
    VRD(5); SBAR(); GAPA(C1=__builtin_amdgcn_mfma_f32_32x32x16_bf16(kf[3],qr[1],C1,0,0,0),   P0[14],P0[15],P1[0],P1[1],   pw1[2]=PKW(P0,12),pw1[3]=PKW(P0,14), pw1); \
    VRD(2); SBAR(); GAPA(C0=__builtin_amdgcn_mfma_f32_32x32x16_bf16(kf[4],qr[2],C0,0,0,0),   P1[2],P1[3],P1[4],P1[5],     pw2[0]=PKW(P1,0), pw2[1]=PKW(P1,2), pw2); \
    VRD(6); SBAR(); GAPA(C1=__builtin_amdgcn_mfma_f32_32x32x16_bf16(kf[5],qr[2],C1,0,0,0),   P1[6],P1[7],P1[8],P1[9],     pw2[2]=PKW(P1,4), pw2[3]=PKW(P1,6), pw2); \
    VRD(3); SBAR(); GAPA(C0=__builtin_amdgcn_mfma_f32_32x32x16_bf16(kf[6],qr[3],C0,0,0,0),   P1[10],P1[11],P1[12],P1[13], pw3[0]=PKW(P1,8), pw3[1]=PKW(P1,10), pw3); \
    VRD(7); SBAR(); GAPA(C1=__builtin_amdgcn_mfma_f32_32x32x16_bf16(kf[7],qr[3],C1,0,0,0),   P1[14],P1[15],0.f,0.f,       pw3[2]=PKW(P1,12),pw3[3]=PKW(P1,14), pw3); \
    l_reg+=sacc; \
    if(GK){DMA_K(PT((t)+3),sl_cur);} if(GV){DMA_V(PT((t)+1),sl_next);} \
    CMASK(C0,C1,t); \
    { float a=MX3(C0[0],C0[1],C1[0]),b=MX3(C0[2],C0[3],C1[1]); a=MX3(a,C1[2],C1[3]); \
      _Pragma("unroll") for(int r=4;r<16;r+=4){a=MX3(a,C0[r],C0[r+1]);b=MX3(b,C0[r+2],C0[r+3]);a=MX3(a,C1[r],C1[r+1]);b=MX3(b,C1[r+2],C1[r+3]);} \
      float rm=__builtin_fmaxf(a,b); { auto rr=__builtin_amdgcn_permlane32_swap(__float_as_uint(rm),__float_as_uint(rm),false,false); rm=__builtin_fmaxf(__uint_as_float(rr[0]),__uint_as_float(rr[1])); } \
      resc=false; \
      if(__builtin_expect(__any(rm>(float)THRL),0)){ const float dl=__builtin_fmaxf(rm,0.f); mhat+=dl; \
        _Pragma("unroll") for(int r=0;r<16;++r){C0[r]-=dl;C1[r]-=dl;} \
        const float f=__builtin_amdgcn_exp2f(-dl); l_reg*=f; if(hi==0)wsf[r32]=f; resc=true; } } \
    SBAR(); \
    GAPB(o[0]=__builtin_amdgcn_mfma_f32_32x32x16_bf16(PAF(0),VFR(0),o[0],0,0,0), C0,0); \
    GAPB(o[1]=__builtin_amdgcn_mfma_f32_32x32x16_bf16(PAF(0),VFR(4),o[1],0,0,0), C0,4); \
    KRD(GL,0); GAPB(o[0]=__builtin_amdgcn_mfma_f32_32x32x16_bf16(PAF(1),VFR(1),o[0],0,0,0), C0,8); \
    KRD(GL,1); GAPB(o[1]=__builtin_amdgcn_mfma_f32_32x32x16_bf16(PAF(1),VFR(5),o[1],0,0,0), C0,12); \
    KRD(GL,2); GAPB(o[0]=__builtin_amdgcn_mfma_f32_32x32x16_bf16(PAF(2),VFR(2),o[0],0,0,0), C1,0); \
    KRD(GL,3); GAPB(o[1]=__builtin_amdgcn_mfma_f32_32x32x16_bf16(PAF(2),VFR(6),o[1],0,0,0), C1,4); \
    GAPB(o[0]=__builtin_amdgcn_mfma_f32_32x32x16_bf16(PAF(3),VFR(3),o[0],0,0,0), C1,8); \
    GAPB(o[1]=__builtin_amdgcn_mfma_f32_32x32x16_bf16(PAF(3),VFR(7),o[1],0,0,0), C1,12); \
    }while(0)

#define ENDW(tt) do { if ((tt) + 3 < NT) { WAIT_BAR(2); } else if ((tt) + 2 < NT) { WAIT_BAR(1); } else { WAIT_BAR(0); } } while (0)
    int t = 1;
    for (; t + 1 < NT; t += 2) {
        STEP(pB0, pB1, pA0, pA1, t, (t + 3 < NT), (t + 1 < NT), (t + 1 < NT));       ENDW(t);     RESC(); ROT();
        STEP(pA0, pA1, pB0, pB1, t + 1, (t + 4 < NT), (t + 2 < NT), (t + 2 < NT));   ENDW(t + 1); RESC(); ROT();
    }
    STEP(pB0, pB1, pA0, pA1, NT - 1, false, false, false); RESC();
    { float sacc = pB0[0] + pB0[1];
#pragma unroll
      for (int r = 2; r < 16; ++r) sacc += pB0[r];
#pragma unroll
      for (int r = 0; r < 16; ++r) sacc += pB1[r];
      l_reg += sacc;
      pw0 = (v4u){PKW(pB0, 0), PKW(pB0, 2), PKW(pB0, 4), PKW(pB0, 6)}; pw1 = (v4u){PKW(pB0, 8), PKW(pB0, 10), PKW(pB0, 12), PKW(pB0, 14)};
      pw2 = (v4u){PKW(pB1, 0), PKW(pB1, 2), PKW(pB1, 4), PKW(pB1, 6)}; pw3 = (v4u){PKW(pB1, 8), PKW(pB1, 10), PKW(pB1, 12), PKW(pB1, 14)};
      SBAR(); pv(o, vb0 + sl_cur, PAF(0), PAF(1), PAF(2), PAF(3)); }
#undef PKW
#undef PAF
#undef VFR
#undef PIN
#undef MX3
#undef GAPA
#undef GAPB
#undef EX
#undef VRD
#undef KRD
#undef STEP
#undef ENDW
    { auto rr = __builtin_amdgcn_permlane32_swap(__float_as_uint(l_reg), __float_as_uint(l_reg), false, false); l_reg = __uint_as_float(rr[0]) + __uint_as_float(rr[1]); }
    if (hi == 0) wsf[32 + r32] = l_reg;
    asm volatile("s_waitcnt lgkmcnt(0)" ::: "memory");
    float rli[16];
#pragma unroll
    for (int r = 0; r < 16; ++r) rli[r] = __builtin_amdgcn_rcpf(wsf[32 + crow(r, hi)]);
    LAS bf16* stg = (LAS bf16*)(shm + F_OST) + wid * 2048;
#pragma unroll
    for (int r = 0; r < 16; ++r) { const int orow = crow(r, hi);
#pragma unroll
        for (int d0 = 0; d0 < 2; ++d0) stg[orow * 64 + d0 * 32 + r32] = (bf16)f2bf(o[d0][r] * rli[r]); }
    asm volatile("s_waitcnt lgkmcnt(0)" ::: "memory");
    bf16* Ow = F.Y() + (rowbase + q0 + wid * 32) * DM + Y_C + h * 64;
#pragma unroll
    for (int i = 0; i < 4; ++i) { const int row = i * 8 + (lane >> 3), ch = lane & 7; const v4u v = *(const LAS v4u*)(stg + row * 64 + ch * 8); *(v4u*)(Ow + (long)row * DM + ch * 8) = v; }
    asm volatile("s_waitcnt lgkmcnt(0)\n\ts_barrier" ::: "memory");
#undef DMA_K
#undef DMA_V
#undef PT
#undef INITC
#undef CMASK
#undef RESC
#undef ROT
}
#undef SBAR
#undef WAIT_BAR
}

__device__ __forceinline__ void ycnorm_rows(const Frame& F) {
    const int gw = F.vcu * NWAVES + F.wave, NGW = F.G * NWAVES;
    for (int m = gw; m < M; m += NGW) { bf16* p = F.Y() + (size_t)m * DM + Y_C + F.lane * 8; float v[8]; unpack8(*(const v4u*)p, v); float s = 0.f;
#pragma unroll
        for (int j = 0; j < 8; ++j) s += v[j] * v[j];
        s = wave_sum(s); const float rs = rsqrtf(s * (1.f / 512.f) + EPS);
#pragma unroll
        for (int j = 0; j < 8; ++j) v[j] *= rs;
        *(v4u*)p = pack8(v); }
}
__device__ __forceinline__ void final_norm_rows(const Frame& F) {
    const int gw = F.vcu * NWAVES + F.wave, NGW = F.G * NWAVES;
    for (int m = gw; m < M; m += NGW) { GAS f32x4* xr = (GAS f32x4*)(F.out + (size_t)m * DM) + F.lane; const f32x4 s4 = *(const f32x4*)(F.SSQ() + (size_t)m * 4);
        const float rs = rsqrtf(((s4[0] + s4[1]) + (s4[2] + s4[3])) * (1.f / DM) + EPS);
#pragma unroll
        for (int j = 0; j < 4; ++j) { const f32x4 g = *((const f32x4*)F.norm_final() + F.lane + 64 * j); xr[64 * j] = xr[64 * j] * rs * g; } }
}

struct Args { const float* in[19]; float* out; unsigned char* ws; int ph_lo, ph_hi, use_bar, pad; };
__global__ void __launch_bounds__(NWAVES * 64, 2) mk_fwd(Args args) {
    __shared__ __attribute__((aligned(16))) unsigned char lds[LDS_BYTES];
    Frame F;
    F.lds = (LAS unsigned char*)lds;
    F.tid = threadIdx.x; F.lane = F.tid & 63; F.wave = __builtin_amdgcn_readfirstlane(F.tid >> 6);
    F.G = gridDim.x; { const int bx = blockIdx.x; F.vcu = (F.G % 8 == 0) ? (bx % 8) * (F.G / 8) + bx / 8 : bx; }
    const int vcu0 = F.vcu; const int wave0 = __builtin_amdgcn_readfirstlane((int)threadIdx.x >> 6);
    F.ka = (const unsigned char*)__builtin_amdgcn_kernarg_segment_ptr(); F.ws = args.ws; F.out = args.out;
    unsigned char* ws = args.ws;
    for (int u = F.tid; u < (LDS_BYTES - LDSCTL_OFF) / 4; u += NWAVES * 64) ((LAS unsigned*)(F.lds + LDSCTL_OFF))[u] = 0u;
    __syncthreads();
    XcdBarrier bar; bar.bar = (unsigned*)(ws + WS_CTL) + CW_BAR; bar.x = 0; bar.st = nullptr;
    if (args.use_bar) bar = xcd_barrier_post((unsigned*)(ws + WS_CTL) + CW_BAR, (volatile LAS unsigned*)(F.lds + MISC_OFF) + 8);

    bool dup_done = false; (void)dup_done;
    for (int ph = args.ph_lo; ph < args.ph_hi; ++ph) {
        {
            int w_i = wave0; asm volatile("" : "+s"(w_i)); int l_i = (int)__builtin_amdgcn_mbcnt_hi(~0u, __builtin_amdgcn_mbcnt_lo(~0u, 0u)); asm volatile("" : "+v"(l_i));
            F.wave = w_i; F.lane = l_i; F.tid = w_i * 64 + l_i;
            int v_ = vcu0; asm volatile("" : "+s"(v_)); F.vcu = v_;
            unsigned char* w_ = args.ws; asm volatile("" : "+s"(w_)); F.ws = w_;
            float* o_ = args.out; asm volatile("" : "+s"(o_)); F.out = o_;
        }
        const int l = (ph - 1) >> 3, k = (ph == 0) ? -1 : (ph == NPH - 1 ? 8 : ((ph - 1) & 7));
        if (k == -1) {
            p0_prologue(F);
        } else if (k == 0) {
            pg8::Gemm g{F.XB(), F.WIN() + (size_t)l * DIN * DM, M, DIN, DM}; pg8::StaticOrder S; S.init(M, DIN, F.G, (int)blockIdx.x);
            pg8::EpiScale<0> E{F.Z(), DIN, F.SSQ(), 1.f / DM, EPS, Z_CQ, Z_CK, C2};
            pg8::gemm_phase<pg8::EpiScale<0>, pg8::StaticOrder, true, true>(F.lds, g, S, E, F.tid);
        } else if (k == 1) {
            for (int it = F.vcu; it < 1024 + 512 + 256; it += F.G) {
                if (it < 1024) hg_unit(F, l, it, false);
                else if (it < 1536) lru_unit(F, l, it - 1024, false);
                else kmean_unit(F, it - 1536);
            }
        } else if (k == 2) {
            for (int it = F.vcu; it < 256 + 512 + 16; it += F.G) {
                if (it < 256) select_unit(F, it);
                else if (it < 768) hg_scan_item(F, it - 256);
                else lru_scan_item(F, it - 768);
            }
        } else if (k == 3) {
            { const int bh = F.vcu >> 4, s = F.vcu & 15;
              if (bh < 16) { moba::attn_unit_fast<8>(F, bh >> 3, bh & 7, 31 - s); moba::attn_unit_fast<8>(F, bh >> 3, bh & 7, s); } }
            for (int it = F.vcu; it < 1024 + 512; it += F.G) {
                if (it < 1024) hg_unit(F, l, it, true); else lru_unit(F, l, it - 1024, true);
            }
        } else if (k == 4) {
#if defined(DBG_REP4)
            if (DBG_REP4 == 2) for (int it = F.vcu; it < 1024; it += F.G) hg_unit(F, l, it, true);
            if (DBG_REP4 == 3) for (int it = F.vcu; it < 512; it += F.G) lru_unit(F, l, it, true);
            __syncthreads();
#endif
            ycnorm_rows(F);
        } else if (k == 5) {
            pg8::Gemm g{F.Y(), F.WOUT() + (size_t)l * DM * DM, M, DM, DM}; pg8::StaticOrder S; S.init(M, DM, F.G, (int)blockIdx.x);
            pg8::EpiRes E{l == 0 ? F.x() : F.out, F.out, F.XB(), F.SSQ(), DM};
            pg8::gemm_phase<pg8::EpiRes, pg8::StaticOrder, false, true>(F.lds, g, S, E, F.tid);
        } else if (k == 6) {
            pg8::Gemm g{F.XB(), F.W1() + (size_t)l * FF * DM, M, FF, DM}; pg8::StaticOrder S; S.init(M, FF, F.G, (int)blockIdx.x);
            pg8::EpiScale<1> E{F.H(), FF, F.SSQ(), 1.f / DM, EPS, 0, 0, 1.f};
            pg8::gemm_phase<pg8::EpiScale<1>, pg8::StaticOrder, true, true>(F.lds, g, S, E, F.tid);
        } else if (k == 7) {
            pg8::Gemm g{F.H(), F.W2() + (size_t)l * DM * FF, M, DM, FF}; pg8::StaticOrder S; S.init(M, DM, F.G, (int)blockIdx.x);
            pg8::EpiRes E{F.out, F.out, F.XB(), F.SSQ(), DM};
            pg8::gemm_phase<pg8::EpiRes, pg8::StaticOrder, false, true>(F.lds, g, S, E, F.tid);
        } else {
            final_norm_rows(F);
        }
        if (ph + 1 < args.ph_hi) xcd_barrier(bar);
#if defined(DBG_DUP)
        if (k == DBG_DUP && !dup_done) { dup_done = true; --ph; } else dup_done = false;
#endif
    }
}


#ifndef DBG_STOP
#define DBG_STOP 0
#endif
#if DBG_STOP
__global__ void dbg_dump(float* out, const unsigned char* ws, int keep_out) {
    const size_t n = (size_t)M * DM;
    for (size_t i = (size_t)blockIdx.x * blockDim.x + threadIdx.x; i < n; i += (size_t)gridDim.x * blockDim.x) {
        float v = 0.f; if (keep_out) { float t = out[i]; v = (t == t && fabsf(t) < 1e30f) ? t : 1e21f; }
        const bf16* big = (const bf16*)(ws + WS_Z);
        for (int q = 0; q < 4; ++q) { float t = bf1(big[i + (size_t)q * n]); const int cc = (int)(i % 1024); const float sen = q < 3 ? 1e9f : (cc < 256 ? 1e12f : (cc < 512 ? 1e15f : 1e18f)); v += (t == t && fabsf(t) < 1e30f) ? t : sen; }
        const float* sm = (const float*)(ws + 1 * MiB); { const size_t si = i % (4 * MiB / 4); float t = (si >= 128 * 1024 && si < 256 * 1024) ? 0.f : sm[si]; v += (t == t && fabsf(t) < 1e30f) ? t : 1e12f; }
        const float* hs = (const float*)(ws + WS_HGS); { float t = hs[i % (16 * MiB / 4)]; v += (t == t && fabsf(t) < 1e30f) ? t : 1e15f; }
        const bf16* xb = (const bf16*)(ws + WS_XB); { float t = bf1(xb[i]); v += (t == t && fabsf(t) < 1e30f) ? t : 1e18f; }
        out[i] = v;
    }
}
#endif
extern "C" void kernel_launch(void* const* d_in, const int* in_sizes, int n_in, void* d_out, int out_size, void* d_ws, size_t ws_size, hipStream_t stream) {
    if (n_in != 19 || out_size != M * DM || ws_size < WS_END) { fprintf(stderr, "kernel_launch: unexpected shapes (n_in %d, out %d, ws %zu)\n", n_in, out_size, ws_size); return; }
    const int grid = 256;
    (void)hipMemsetAsync((char*)d_ws + WS_CTL, 0, CTL_ZERO_BYTES, stream);
    Args a{};
    for (int i = 0; i < 19; ++i) a.in[i] = (const float*)d_in[i];
    a.out = (float*)d_out; a.ws = (unsigned char*)d_ws;
#if MK_ONE_LAUNCH
    a.ph_lo = 0; a.ph_hi = NPH; a.use_bar = 1;
    hipLaunchKernelGGL(mk_fwd, dim3(grid), dim3(NWAVES * 64), 0, stream, a);
#else
#if DBG_STOP
    const int nph = DBG_STOP;
#else
    const int nph = NPH;
#endif
    for (int ph = 0; ph < nph; ++ph) { a.ph_lo = ph; a.ph_hi = ph + 1; a.use_bar = 0; hipLaunchKernelGGL(mk_fwd, dim3(grid), dim3(NWAVES * 64), 0, stream, a); }
#if DBG_STOP
    hipLaunchKernelGGL(dbg_dump, dim3(2048), dim3(256), 0, stream, (float*)d_out, (const unsigned char*)d_ws, (int)(DBG_STOP >= 7));
#endif
#endif
}
```

```cpp
#include <hip/hip_runtime.h>
#include <hip/hip_bf16.h>
#include <cstdio>
#include <cstdint>
#include <cmath>
namespace pg8 {
#define PG8_LAS __attribute__((address_space(3)))
typedef unsigned short bf16_t;
typedef short bf16x8 __attribute__((ext_vector_type(8)));
typedef float f32x4 __attribute__((ext_vector_type(4)));
typedef unsigned u32x4 __attribute__((ext_vector_type(4)));
constexpr int BM = 256, BK = 64, HALF = 128, HTB = HALF * BK * 2  , STAGE_BYTES = 8 * HTB, NXCD = 8, WGM = 8;

__host__ __device__ __forceinline__ int lds_byte(int r, int c) { const int st = (r >> 4) * 2 + (c >> 5), rr = r & 15, cc = c & 31, ob = rr * 64 + cc * 2; return st * 1024 + (ob ^ (((ob >> 9) & 1) << 5)); }
__host__ __device__ __forceinline__ void stage_rc(int b, int& R, int& C) { const int st = b / 1024, sb = b % 1024, swz = sb ^ (((sb >> 9) & 1) << 5); R = (st >> 1) * 16 + swz / 64; C = (st & 1) * 32 + (swz % 64) / 2; }
__host__ __device__ __forceinline__ int perm32(int rho) { const int n = rho >> 4, i = rho & 15; return 8 * (i >> 2) + 4 * n + (i & 3); }

struct Unit { int pm, pn; };
struct Gemm { const bf16_t* A; const bf16_t* Bt; int M, N, K; };

struct StaticOrder {
    int nM, nN, nwg, G, c;
    __host__ __device__ void init(int M, int N, int G_, int c_) { nM = M / BM; nN = N / BM; nwg = nM * nN; G = G_; c = c_; }
    __host__ __device__ bool next(int i, Unit& u) const {
        const long L = (long)i * G + c; if (L >= nwg) return false;
        int wgid = (int)L; { const int q = nwg / NXCD, r = nwg % NXCD, xcd = wgid % NXCD, off = wgid / NXCD; wgid = (xcd < r ? xcd * (q + 1) : r * (q + 1) + (xcd - r) * q) + off; }
        const int nig = WGM * nN, gid = wgid / nig, fm = gid * WGM, gsz = (nM - fm) < WGM ? (nM - fm) : WGM;
        u.pm = fm + ((wgid % nig) % gsz); u.pn = (wgid % nig) / gsz; return true;
    }
    __device__ __forceinline__ void a_ready(const Unit&) const {}
    __device__ __forceinline__ void done(const Unit&) const {}
};
__device__ __forceinline__ unsigned cvt_pk_bf16(float lo, float hi) { unsigned r; asm volatile("v_cvt_pk_bf16_f32 %0, %1, %2" : "=v"(r) : "v"(lo), "v"(hi)); return r; }
typedef float f32x2 __attribute__((ext_vector_type(2)));
typedef unsigned u32x2 __attribute__((ext_vector_type(2)));
template <int ACT> struct EpiScale {
    static constexpr bool PERM = true, AFTER_DRAIN = false;
    bf16_t* O; int ldc; const float* ssq; float inv_k, eps; int sc_lo, sc_hi; float sc;
    __device__ __forceinline__ void operator()(const f32x4 (&acc)[2][2][4][2], const Unit& u, int wr, int wc, int fr, int fq) const {
        const int row0 = u.pm * BM + wr * 64 + fr; const int colt = u.pn * BM;
        const float cs = (colt >= sc_lo && colt < sc_hi) ? sc : 1.f;
        const int col0 = colt + wc * 32 + 8 * fq;
#pragma unroll
        for (int ai = 0; ai < 2; ++ai)
#pragma unroll
            for (int m = 0; m < 4; ++m) { const int row = row0 + ai * HALF + m * 16;
                const f32x4 s4 = *(const f32x4*)(ssq + (size_t)row * 4);
                const float rs = rsqrtf(((s4[0] + s4[1]) + (s4[2] + s4[3])) * inv_k + eps) * cs;
                bf16_t* rowp = O + (size_t)row * ldc + col0;
#pragma unroll
                for (int bj = 0; bj < 2; ++bj) { f32x4 v0 = acc[ai][bj][m][0] * rs, v1 = acc[ai][bj][m][1] * rs;
                    if (ACT == 1) {
#pragma unroll
                        for (int e = 0; e < 4; ++e) { const float a0 = fmaxf(v0[e], 0.f), a1 = fmaxf(v1[e], 0.f); v0[e] = a0 * a0; v1[e] = a1 * a1; } }
                    u32x4 w; w.x = cvt_pk_bf16(v0[0], v0[1]); w.y = cvt_pk_bf16(v0[2], v0[3]); w.z = cvt_pk_bf16(v1[0], v1[1]); w.w = cvt_pk_bf16(v1[2], v1[3]);
                    *(u32x4*)(rowp + bj * HALF) = w; } }
    }
};
struct EpiRes {
    static constexpr bool PERM = false, AFTER_DRAIN = true;
    const float* base; float* out; bf16_t* xb; float* ssq; int ldc;
    __device__ __forceinline__ void fused(f32x4 (&acc)[2][2][4][2], const Unit& u, int wr, int wc, int fr, int fq, PG8_LAS unsigned char* lds, int wid, int lane) const {
        PG8_LAS float* P = (PG8_LAS float*)lds;
#if defined(DBG_ZACC)
#pragma unroll
        for (int a_ = 0; a_ < 2; ++a_)
#pragma unroll
            for (int b_ = 0; b_ < 2; ++b_)
#pragma unroll
                for (int m_ = 0; m_ < 4; ++m_)
#pragma unroll
                    for (int n_ = 0; n_ < 2; ++n_) acc[a_][b_][m_][n_] = (f32x4){0.f, 0.f, 0.f, 0.f};
#endif
        const int col0 = u.pn * BM + wc * 32 + 4 * fq;
#pragma unroll
        for (int ai = 0; ai < 2; ++ai)
#pragma unroll
            for (int m = 0; m < 4; ++m) { const int r = ai * HALF + wr * 64 + m * 16 + fr; const size_t off = (size_t)(u.pm * BM + r) * ldc + col0; float ps = 0.f;
#pragma unroll
                for (int bj = 0; bj < 2; ++bj)
#pragma unroll
                    for (int n = 0; n < 2; ++n) { const f32x4 bs = *(const f32x4*)(base + off + bj * HALF + n * 16); const f32x4 o = bs + acc[ai][bj][m][n];
                        *(f32x4*)(out + off + bj * HALF + n * 16) = o; ps += (o[0] * o[0] + o[1] * o[1]) + (o[2] * o[2] + o[3] * o[3]);
                        u32x2 w; w.x = cvt_pk_bf16(o[0], o[1]); w.y = cvt_pk_bf16(o[2], o[3]); *(u32x2*)(xb + off + bj * HALF + n * 16) = w; }
                ps += __shfl_xor(ps, 16); ps += __shfl_xor(ps, 32);
                if (fq == 0) P[r * 4 + wc] = ps;
                if (m & 1) asm volatile("" ::: "memory"); }
        __syncthreads();
        const int t = wid * 64 + lane;
        if (t < 256) ssq[(size_t)(u.pm * BM + t) * 4 + u.pn] = (P[t * 4] + P[t * 4 + 1]) + (P[t * 4 + 2] + P[t * 4 + 3]);
    }
};
template <class Epi, class Sched, bool ALIGN_EPI = false, bool SP2 = false>
__device__ __forceinline__ void gemm_phase(PG8_LAS unsigned char* lds, const Gemm g, const Sched& S, const Epi& E, const int tid_in) {
    int tid_l = tid_in; asm volatile("" : "+v"(tid_l));
    const int tid = tid_l, wid = __builtin_amdgcn_readfirstlane(tid >> 6), lane = tid & 63, wr = wid >> 2, wc = wid & 3, fr = lane & 15, fq = lane >> 4;
    const int K = g.K, nt = K / BK;
    unsigned voffA[2], voffB[2];
#pragma unroll
    for (int i = 0; i < 2; ++i) { int R, C; stage_rc(tid * 16 + i * 8192, R, C); const int Rb = Epi::PERM ? ((R & ~31) + perm32(R & 31)) : R;
        voffA[i] = (unsigned)(R * K + C) * 2u; voffB[i] = (unsigned)(Rb * K + C) * 2u; }
    const size_t kstep = (size_t)(BK * 2);
    const size_t hstep = (size_t)HALF * K * 2;
    const size_t tstep = 2 * hstep;
    const unsigned ldsw = (unsigned)wid * 1024u;
    const int aoff = lds_byte(wr * 64 + fr, fq * 8), boff = lds_byte(wc * 32 + fr, fq * 8);
#define PG8_SA(b, h) (((b) * 2 + (h)) * HTB)
#define PG8_SB(b, h) ((4 + (b) * 2 + (h)) * HTB)
#define PG8_STAGE(bufoff, gbase, voff) do { _Pragma("unroll") for (int _i = 0; _i < 2; ++_i) \
        __builtin_amdgcn_global_load_lds((const unsigned*)((const char*)(gbase) + (voff)[_i]), (PG8_LAS unsigned*)(lds + (bufoff) + ldsw + _i * 8192), 16, 0, 0); } while (0)
#define PG8_LDA(dst, b, h) do { _Pragma("unroll") for (int m = 0; m < 4; ++m) _Pragma("unroll") for (int k = 0; k < 2; ++k) dst[m][k] = *(const PG8_LAS bf16x8*)(lds + PG8_SA(b, h) + aoff + m * 2048 + k * 1024); } while (0)
#define PG8_LDB(dst, b, h) do { _Pragma("unroll") for (int n = 0; n < 2; ++n) _Pragma("unroll") for (int k = 0; k < 2; ++k) dst[n][k] = *(const PG8_LAS bf16x8*)(lds + PG8_SB(b, h) + boff + n * 2048 + k * 1024); } while (0)
#define PG8_MMA(ai, bj, At, Bt) do { __builtin_amdgcn_s_setprio(1); _Pragma("unroll") for (int m = 0; m < 4; ++m) _Pragma("unroll") for (int n = 0; n < 2; ++n) _Pragma("unroll") for (int k = 0; k < 2; ++k) \
        acc[ai][bj][m][n] = __builtin_amdgcn_mfma_f32_16x16x32_bf16(Bt[n][k], At[m][k], acc[ai][bj][m][n], 0, 0, 0); __builtin_amdgcn_s_setprio(0); } while (0)
#define PG8_WAIT_V(n) asm volatile("s_waitcnt vmcnt(" #n ")" ::: "memory")
#define PG8_WAIT_L(n) asm volatile("s_waitcnt lgkmcnt(" #n ")" ::: "memory")
#define PG8_BAR __builtin_amdgcn_s_barrier()
#define PG8_SCHED __builtin_amdgcn_sched_barrier(0)
    Unit cur, nxt; int ui = 0;
    if (!S.next(0, cur)) return;
    f32x4 acc[2][2][4][2];
#pragma unroll
    for (int a = 0; a < 2; ++a)
#pragma unroll
        for (int b = 0; b < 2; ++b)
#pragma unroll
            for (int m = 0; m < 4; ++m)
#pragma unroll
                for (int n = 0; n < 2; ++n) acc[a][b][m][n] = (f32x4){0.f, 0.f, 0.f, 0.f};
    bf16x8 At[4][2], B0[2][2], B1[2][2];
    const char* cA = (const char*)g.A + (size_t)cur.pm * tstep; const char* cB = (const char*)g.Bt + (size_t)cur.pn * tstep;
    S.a_ready(cur);
    if constexpr (SP2) {
        PG8_STAGE(PG8_SB(0, 0), cB, voffB); PG8_STAGE(PG8_SB(0, 1), cB + hstep, voffB); PG8_STAGE(PG8_SA(0, 0), cA, voffA); PG8_STAGE(PG8_SA(0, 1), cA + hstep, voffA);
        if (wr == 1) PG8_BAR;
        PG8_WAIT_V(2); PG8_BAR;
        PG8_STAGE(PG8_SB(1, 0), cB + kstep, voffB); PG8_STAGE(PG8_SA(1, 0), cA + kstep, voffA); PG8_STAGE(PG8_SB(1, 1), cB + hstep + kstep, voffB);
        PG8_WAIT_V(6); PG8_BAR;
    } else {
        PG8_STAGE(PG8_SB(0, 0), cB, voffB); PG8_STAGE(PG8_SA(0, 0), cA, voffA); PG8_STAGE(PG8_SB(0, 1), cB + hstep, voffB); PG8_STAGE(PG8_SA(0, 1), cA + hstep, voffA);
        if (wr == 1) PG8_BAR;
        PG8_WAIT_V(4); PG8_BAR;
        PG8_STAGE(PG8_SB(1, 0), cB + kstep, voffB); PG8_STAGE(PG8_SA(1, 0), cA + kstep, voffA); PG8_STAGE(PG8_SB(1, 1), cB + hstep + kstep, voffB);
        PG8_WAIT_V(6); PG8_BAR;
    }
    for (;;) {
        const bool has_next = S.next(ui + 1, nxt);
        const char* nA = has_next ? (const char*)g.A + (size_t)nxt.pm * tstep : cA; const char* nB = has_next ? (const char*)g.Bt + (size_t)nxt.pn * tstep : cB;
        for (int t = 0; t < nt; t += 2) {
            const bool last = (t == nt - 2);
            const char* a1 = cA + (size_t)(t + 1) * kstep;
            const char* a2 = last ? nA : cA + (size_t)(t + 2) * kstep; const char* b2 = last ? nB : cB + (size_t)(t + 2) * kstep;
            const char* a3 = a2 + kstep; const char* b3 = b2 + kstep;
            if (last && has_next) S.a_ready(nxt);
            if constexpr (SP2) {
            PG8_LDB(B0, 0, 0); PG8_LDB(B1, 0, 1); PG8_SCHED; PG8_LDA(At, 0, 0); PG8_STAGE(PG8_SA(1, 1), a1 + hstep, voffA);
            PG8_WAIT_V(8); PG8_WAIT_L(0); PG8_BAR; PG8_MMA(0, 0, At, B0); PG8_MMA(0, 1, At, B1); PG8_BAR; PG8_SCHED;
            PG8_LDA(At, 0, 1); PG8_STAGE(PG8_SB(0, 0), b2, voffB); PG8_STAGE(PG8_SB(0, 1), b2 + hstep, voffB); PG8_STAGE(PG8_SA(0, 0), a2, voffA);
            PG8_WAIT_V(8); PG8_WAIT_L(0); PG8_BAR; PG8_MMA(1, 0, At, B0); PG8_MMA(1, 1, At, B1); PG8_BAR; PG8_SCHED;
            PG8_LDB(B0, 1, 0); PG8_LDB(B1, 1, 1); PG8_SCHED; PG8_LDA(At, 1, 0); PG8_STAGE(PG8_SA(0, 1), a2 + hstep, voffA);
            PG8_WAIT_V(8); PG8_WAIT_L(0); PG8_BAR; PG8_MMA(0, 0, At, B0); PG8_MMA(0, 1, At, B1); PG8_BAR; PG8_SCHED;
            PG8_LDA(At, 1, 1); PG8_STAGE(PG8_SB(1, 0), b3, voffB); PG8_STAGE(PG8_SB(1, 1), b3 + hstep, voffB); PG8_STAGE(PG8_SA(1, 0), a3, voffA);
            PG8_WAIT_V(8); PG8_WAIT_L(0); PG8_BAR; PG8_MMA(1, 0, At, B0); PG8_MMA(1, 1, At, B1); PG8_BAR; PG8_SCHED;
            } else {
            PG8_LDB(B0, 0, 0); PG8_SCHED; PG8_LDA(At, 0, 0); PG8_STAGE(PG8_SA(1, 1), a1 + hstep, voffA);
            PG8_WAIT_L(8); PG8_BAR; PG8_WAIT_L(0); PG8_MMA(0, 0, At, B0); PG8_BAR; PG8_SCHED;
            PG8_LDB(B1, 0, 1); PG8_STAGE(PG8_SB(0, 0), b2, voffB);
            PG8_BAR; PG8_WAIT_L(0); PG8_MMA(0, 1, At, B1); PG8_BAR;
            PG8_LDA(At, 0, 1); PG8_STAGE(PG8_SA(0, 0), a2, voffA);
            PG8_BAR; PG8_WAIT_L(0); PG8_MMA(1, 0, At, B0); PG8_BAR; PG8_SCHED;
            PG8_STAGE(PG8_SB(0, 1), b2 + hstep, voffB);
            PG8_WAIT_V(6); PG8_BAR; PG8_MMA(1, 1, At, B1); PG8_BAR;
            PG8_LDB(B0, 1, 0); PG8_SCHED; PG8_LDA(At, 1, 0); PG8_STAGE(PG8_SA(0, 1), a2 + hstep, voffA);
            PG8_WAIT_L(8); PG8_BAR; PG8_WAIT_L(0); PG8_MMA(0, 0, At, B0); PG8_BAR; PG8_SCHED;
            PG8_LDB(B1, 1, 1); PG8_STAGE(PG8_SB(1, 0), b3, voffB);
            PG8_BAR; PG8_WAIT_L(0); PG8_MMA(0, 1, At, B1); PG8_BAR;
            PG8_LDA(At, 1, 1); PG8_STAGE(PG8_SA(1, 0), a3, voffA);
            PG8_BAR; PG8_WAIT_L(0); PG8_MMA(1, 0, At, B0); PG8_BAR; PG8_SCHED;
            PG8_STAGE(PG8_SB(1, 1), b3 + hstep, voffB);
            PG8_WAIT_V(6); PG8_BAR; PG8_MMA(1, 1, At, B1); PG8_BAR;
            }
        }
        if constexpr (ALIGN_EPI) { if (wr == 0) PG8_BAR; }
        if constexpr (!Epi::AFTER_DRAIN) { E(acc, cur, wr, wc, fr, fq); S.done(cur); }
        if (!has_next) break;
#pragma unroll
        for (int a = 0; a < 2; ++a)
#pragma unroll
            for (int b = 0; b < 2; ++b)
#pragma unroll
                for (int m = 0; m < 4; ++m)
#pragma unroll
                    for (int n = 0; n < 2; ++n) acc[a][b][m][n] = (f32x4){0.f, 0.f, 0.f, 0.f};
        cur = nxt; cA = nA; cB = nB; ++ui;
        if constexpr (ALIGN_EPI) { if (wr == 1) PG8_BAR; }
    }
    PG8_WAIT_V(0);
    if constexpr (!ALIGN_EPI) { if (wr == 0) PG8_BAR; }
    PG8_BAR;
    if constexpr (Epi::AFTER_DRAIN) { E.fused(acc, cur, wr, wc, fr, fq, lds, wid, lane); S.done(cur); }
#undef PG8_SA
#undef PG8_SB
#undef PG8_STAGE
#undef PG8_LDA
#undef PG8_LDB
#undef PG8_MMA
#undef PG8_WAIT_V
#undef PG8_WAIT_L
#undef PG8_BAR
#undef PG8_SCHED
}
}

constexpr int NWAVES = 8;
constexpr int BATCH = 2, T = 8192, DM = 1024, M = BATCH * T, DIN = 3072, FF = 4096, DEPTH = 2;
constexpr int Z_AX = 0, Z_AY = 256, Z_BQ = 512, Z_BF = 768, Z_BI = 1024, Z_BG = 1280, Z_CQ = 1536, Z_CK = 2048, Z_CV = 2560;
constexpr int Y_A = 0, Y_B = 256, Y_C = 512;
constexpr float EPS = 1e-6f;
constexpr float LOG2E = 1.4426950408889634f;
constexpr float C2 = 0.125f * LOG2E;
constexpr int NPH = 18;
#ifndef MK_ONE_LAUNCH
#define MK_ONE_LAUNCH 1
#endif

constexpr size_t MiB = 1u << 20, KiB = 1024;
constexpr size_t WS_CTL = 0, CTL_ZERO_BYTES = 64 * KiB;
constexpr size_t WS_SSQ = 1 * MiB;
constexpr size_t WS_KMP = 5 * MiB;
constexpr size_t WS_SEL = 1 * MiB + 512 * KiB;
constexpr size_t WS_LRUA = 2 * MiB;
constexpr size_t WS_LRUU = 2 * MiB + 512 * KiB;
constexpr size_t WS_LRUC = 3 * MiB;
constexpr size_t WS_HGD = 3 * MiB + 512 * KiB;
constexpr size_t WS_GW = 4 * MiB;
constexpr size_t WS_LB = 4 * MiB + 256 * KiB;
constexpr size_t WS_SP = 4 * MiB + 260 * KiB;
constexpr size_t WS_WL = 8 * MiB, WL_STRIDE = 24 * MiB;
constexpr size_t WL_WIN = 0, WL_WOUT = 6 * MiB, WL_W1 = 8 * MiB, WL_W2 = 16 * MiB;
constexpr size_t WS_CNT = 5 * MiB + 512 * KiB;
constexpr size_t WS_XB = 56 * MiB;
constexpr size_t WS_HGS = 88 * MiB;
constexpr size_t WS_Z = 104 * MiB;
constexpr size_t WS_Y = 200 * MiB;
constexpr size_t WS_H = 104 * MiB;
constexpr size_t WS_PO0 = 56 * MiB, WS_PO1 = 72 * MiB, WS_PO2 = 232 * MiB, WS_PO3_L1 = 8 * MiB;
constexpr size_t WS_PML = 248 * MiB;
constexpr size_t WS_LIST = 252 * MiB;
constexpr size_t WS_END = 256 * MiB;
constexpr int CW_QCTR = 512;
constexpr int CW_BAR = 1024;

constexpr int RING_BYTES = 131072, LDSCTL_OFF = RING_BYTES, MISC_OFF = LDSCTL_OFF + 320, LDS_BYTES = 147456;

#define GAS __attribute__((address_space(1)))
#define LAS __attribute__((address_space(3)))
typedef unsigned short bf16;
typedef unsigned v4u __attribute__((ext_vector_type(4)));
typedef float f32x4 __attribute__((ext_vector_type(4)));
typedef short bf16x8 __attribute__((ext_vector_type(8)));
typedef float f32x16 __attribute__((ext_vector_type(16)));
typedef short s16x4 __attribute__((ext_vector_type(4)));
#define RLX_AGENT __ATOMIC_RELAXED, __HIP_MEMORY_SCOPE_AGENT
__device__ __forceinline__ unsigned f2bf(float f) { unsigned u = __builtin_bit_cast(unsigned, f); return (u + 0x7fffu + ((u >> 16) & 1u)) >> 16; }
__device__ __forceinline__ unsigned pk2(float lo, float hi) { return f2bf(lo) | (f2bf(hi) << 16); }
__device__ __forceinline__ float bflo(unsigned u) { return __uint_as_float(u << 16); }
__device__ __forceinline__ float bfhi(unsigned u) { return __uint_as_float(u & 0xffff0000u); }
__device__ __forceinline__ float bf1(bf16 v) { return __uint_as_float((unsigned)v << 16); }
__device__ __forceinline__ void unpack8(const v4u v, float (&f)[8]) { f[0] = bflo(v.x); f[1] = bfhi(v.x); f[2] = bflo(v.y); f[3] = bfhi(v.y); f[4] = bflo(v.z); f[5] = bfhi(v.z); f[6] = bflo(v.w); f[7] = bfhi(v.w); }
__device__ __forceinline__ v4u pack8(const float (&f)[8]) { v4u v; v.x = pk2(f[0], f[1]); v.y = pk2(f[2], f[3]); v.z = pk2(f[4], f[5]); v.w = pk2(f[6], f[7]); return v; }
__device__ __forceinline__ float sigmoidf_(float x) { return 1.f / (1.f + __expf(-x)); }
__device__ __forceinline__ float wave_sum(float v) {
#pragma unroll
    for (int o = 1; o < 64; o <<= 1) v += __shfl_xor(v, o);
    return v;
}
#define XB_TMO      128
#define XB_XCNT(j)  (256  + 64 * (j))
#define XB_XSUB(j)  (1280 + 64 * (j))
#define XB_XGEN(j)  (2304 + 64 * (j))
#define XB_TOP      3328
#define XB_TOPGEN   3392
#define XCD_BAR_WORDS 3456
#define XB_SPIN_CAP (1u << 18)

__device__ __forceinline__ unsigned xb_ld(unsigned* p)              { return __hip_atomic_load(p, __ATOMIC_RELAXED, __HIP_MEMORY_SCOPE_AGENT); }
__device__ __forceinline__ unsigned xb_add(unsigned* p, unsigned v) { return __hip_atomic_fetch_add(p, v, __ATOMIC_RELAXED, __HIP_MEMORY_SCOPE_AGENT); }
__device__ __forceinline__ unsigned xb_xcc_id() { return (unsigned)__builtin_amdgcn_s_getreg((3 << 11) | 20) & 0xFu; }
#define XB_SPIN(cond, bar) do { unsigned _sp = 0; while (cond) { __builtin_amdgcn_s_sleep(1); \
    if ((++_sp & 255u) == 0u) { if (xb_ld(&(bar)[XB_TMO])) break; if (_sp > XB_SPIN_CAP) { atomicAdd(&(bar)[XB_TMO], 1u); break; } } } } while (0)

struct XcdBarrier {
    unsigned* bar; unsigned x;
    volatile LAS unsigned* st;
};

__device__ __forceinline__ XcdBarrier xcd_barrier_post(unsigned* bar, volatile LAS unsigned* st) {
    XcdBarrier b; b.bar = bar; b.x = xb_xcc_id(); b.st = st;
    if (threadIdx.x == 0) (void)xb_add(&bar[XB_XCNT(b.x)], 1u);
    return b;
}
__device__ __forceinline__ void xcd_barrier_complete(unsigned* bar, unsigned x, unsigned& nloc, unsigned& nx) {
    const unsigned G = gridDim.x * gridDim.y * gridDim.z;
    unsigned sum, cnt, mine, sp = 0u;
    for (;;) {
        sum = 0u; cnt = 0u; mine = 0u;
#pragma unroll
        for (unsigned j = 0; j < 16; ++j) { const unsigned c = xb_ld(&bar[XB_XCNT(j)]); sum += c; cnt += (c > 0u) ? 1u : 0u; mine = (j == x) ? c : mine; }
        if (sum == G) break;
        __builtin_amdgcn_s_sleep(1);
        if ((++sp & 255u) == 0u) { if (xb_ld(&bar[XB_TMO])) break; if (sp > XB_SPIN_CAP) { atomicAdd(&bar[XB_TMO], 1u); break; } }
    }
    nloc = mine > 0u ? mine : 1u; nx = cnt > 0u ? cnt : 1u;
}

__device__ __forceinline__ void xcd_barrier(const XcdBarrier& b) {
    asm volatile("s_waitcnt vmcnt(0)" ::: "memory");
    __syncthreads();
    if (threadIdx.x == 0) {
        unsigned* bar = b.bar;
        __builtin_amdgcn_s_waitcnt(0);
        unsigned nloc = b.st[0], nx = b.st[1];
        if (nloc == 0u) { xcd_barrier_complete(bar, b.x, nloc, nx); b.st[0] = nloc; b.st[1] = nx; }
        const unsigned old = xb_add(&bar[XB_XSUB(b.x)], 1u);
        const unsigned gen = old / nloc;
        if (old + 1u == (gen + 1u) * nloc) {
            __builtin_amdgcn_fence(__ATOMIC_RELEASE, "agent");
            asm volatile("s_waitcnt vmcnt(0)" ::: "memory");
            const unsigned og = xb_add(&bar[XB_TOP], 1u);
            const unsigned tg = og / nx;
            if (og + 1u == (tg + 1u) * nx) xb_add(&bar[XB_TOPGEN], 1u);
            else XB_SPIN(xb_ld(&bar[XB_TOPGEN]) == tg, bar);
            __builtin_amdgcn_fence(__ATOMIC_ACQUIRE, "agent");
            xb_add(&bar[XB_XGEN(b.x)], 1u);
            asm volatile("s_waitcnt vmcnt(0)" ::: "memory");
        } else {
            XB_SPIN(xb_ld(&bar[XB_XGEN(b.x)]) == gen, bar);
            __builtin_amdgcn_fence(__ATOMIC_ACQUIRE, "agent");
            asm volatile("s_waitcnt vmcnt(0)" ::: "memory");
        }
    }
    __syncthreads();
}

struct Frame {
    LAS unsigned char* lds;
    int tid, lane, wave, vcu, G;
    const unsigned char* ka;
    unsigned char* ws; float* out;
    __device__ __forceinline__ Frame fresh() const { Frame G_ = *this; int l_ = lane; asm volatile("" : "+v"(l_)); G_.lane = l_; G_.tid = wave * 64 + l_; return G_; }
    __device__ __forceinline__ const float* in(int i) const { const unsigned char* k = ka; asm volatile("" : "+s"(k)); return *(const float* const*)(k + 8 * i); }
#define FIN(name, idx) __device__ __forceinline__ const float* name() const { return in(idx); }
    FIN(x, 0) FIN(w_in, 1) FIN(w_out, 2) FIN(norm_mix, 3) FIN(norm_mlp, 4) FIN(conv_w, 5) FIN(conv_b, 6) FIN(lru_wa, 7) FIN(lru_ba, 8) FIN(lru_wx, 9) FIN(lru_bx, 10) FIN(lru_lam, 11)
    FIN(hg_lb, 12) FIN(hg_nw, 13) FIN(lru_on, 14) FIN(att_on, 15) FIN(w_ff1, 16) FIN(w_ff2, 17) FIN(norm_final, 18)
#undef FIN
#define FWS(type, name, off) __device__ __forceinline__ type* name() const { return (type*)(ws + (off)); }
    FWS(float, SSQ, WS_SSQ) FWS(float, KMP, WS_KMP) FWS(unsigned, SEL, WS_SEL) FWS(float, LRUA, WS_LRUA) FWS(float, LRUU, WS_LRUU) FWS(float, LRUC, WS_LRUC) FWS(float, HGD, WS_HGD) FWS(float, HGS, WS_HGS)
    FWS(float, LB, WS_LB) FWS(float, SP, WS_SP) FWS(bf16, GW, WS_GW) FWS(unsigned, CNT, WS_CNT) FWS(unsigned char, LIST, WS_LIST) FWS(float, PML, WS_PML) FWS(bf16, XB, WS_XB) FWS(bf16, Z, WS_Z) FWS(bf16, Y, WS_Y) FWS(bf16, H, WS_H)
#undef FWS
    __device__ __forceinline__ bf16* WIN(int l) const { return (bf16*)(ws + WS_WL + l * WL_STRIDE + WL_WIN); }
    __device__ __forceinline__ bf16* WOUT(int l) const { return (bf16*)(ws + WS_WL + l * WL_STRIDE + WL_WOUT); }
    __device__ __forceinline__ bf16* W1(int l) const { return (bf16*)(ws + WS_WL + l * WL_STRIDE + WL_W1); }
    __device__ __forceinline__ bf16* W2(int l) const { return (bf16*)(ws + WS_WL + l * WL_STRIDE + WL_W2); }
    __device__ __forceinline__ bf16* PO(int l, int slot) const { return slot == 0 ? (bf16*)(ws + WS_PO0) : slot == 1 ? (bf16*)(ws + WS_PO1) : slot == 2 ? (bf16*)(ws + WS_PO2) : (l == 0 ? (bf16*)out : (bf16*)(ws + WS_PO3_L1)); }
};

__device__ __forceinline__ float gain_of(const float* g0, const float* g1, int mode, int k) {
    if (mode == 1 || mode == 2) return g0[k];
    if (mode == 3) return k < 256 ? g0[k] : (k < 512 ? 1.f : g1[k - 512]);
    return 1.f;
}
__device__ __forceinline__ void p0_transpose_item(const Frame& F, const float* W, int K, int N, bf16* WT, LAS float* scr, int item, int lane, int mode, int l) {
    const float* g0 = mode == 1 ? F.norm_mix() + l * DM : (mode == 2 ? F.norm_mlp() + l * DM : F.lru_on() + l * 256); const float* g1 = F.att_on() + l * 512;
    const int nblk = N / 32, kb = item / nblk, nb = item % nblk, k0 = 64 * kb, n0 = 32 * nb;
    float wv[32];
#pragma unroll
    for (int i = 0; i < 32; ++i) { const int kk = 2 * i + (lane >> 5); wv[i] = W[(size_t)(k0 + kk) * N + n0 + (lane & 31)]; }
#pragma unroll
    for (int i = 0; i < 32; ++i) { const int kk = 2 * i + (lane >> 5); scr[kk * 33 + (lane & 31)] = wv[i] * gain_of(g0, g1, mode, k0 + kk); }
    asm volatile("s_waitcnt lgkmcnt(0)" ::: "memory");
    const int c = lane & 7;
#pragma unroll
    for (int j = 0; j < 4; ++j) { const int n = (lane >> 3) + 8 * j; const LAS float* s = scr + (8 * c) * 33 + n;
        v4u o; o.x = pk2(s[0 * 33], s[1 * 33]); o.y = pk2(s[2 * 33], s[3 * 33]); o.z = pk2(s[4 * 33], s[5 * 33]); o.w = pk2(s[6 * 33], s[7 * 33]);
        *(GAS v4u*)(WT + (size_t)(n0 + n) * K + k0 + 8 * c) = o; }
    asm volatile("s_waitcnt lgkmcnt(0)" ::: "memory");
}
__device__ __forceinline__ void p0_prologue(const Frame& F) {
    LAS float* scr = (LAS float*)(F.lds + F.wave * 16384);
    const int gw = F.vcu * NWAVES + F.wave, NGW = F.G * NWAVES;
    constexpr int I_IN = (DM / 64) * (DIN / 32), I_OUT = (DM / 64) * (DM / 32), I_1 = (DM / 64) * (FF / 32), I_2 = (FF / 64) * (DM / 32);
    constexpr int PER_L = I_IN + I_OUT + I_1 + I_2;
    for (int it = gw; it < DEPTH * PER_L; it += NGW) {
        const int l = it / PER_L; int r = it % PER_L;
        if (r < I_IN) { p0_transpose_item(F, F.w_in() + (size_t)l * DM * DIN, DM, DIN, F.WIN(l), scr, r, F.lane, 1, l); continue; } r -= I_IN;
        if (r < I_OUT) { p0_transpose_item(F, F.w_out() + (size_t)l * DM * DM, DM, DM, F.WOUT(l), scr, r, F.lane, 3, l); continue; } r -= I_OUT;
        if (r < I_1) { p0_transpose_item(F, F.w_ff1() + (size_t)l * DM * FF, DM, FF, F.W1(l), scr, r, F.lane, 2, l); continue; } r -= I_1;
        p0_transpose_item(F, F.w_ff2() + (size_t)l * FF * DM, FF, DM, F.W2(l), scr, r, F.lane, 0, l);
    }
    for (int m = gw; m < M; m += NGW) {
        const GAS f32x4* xr = (const GAS f32x4*)(F.x() + (size_t)m * DM) + F.lane; f32x4 v[4]; float s = 0.f;
#pragma unroll
        for (int j = 0; j < 4; ++j) { v[j] = xr[64 * j]; s += (v[j].x * v[j].x + v[j].y * v[j].y) + (v[j].z * v[j].z + v[j].w * v[j].w); }
        s = wave_sum(s);
        GAS unsigned long long* o8 = (GAS unsigned long long*)(F.XB() + (size_t)m * DM) + F.lane;
#pragma unroll
        for (int j = 0; j < 4; ++j) o8[64 * j] = (unsigned long long)pk2(v[j].x, v[j].y) | ((unsigned long long)pk2(v[j].z, v[j].w) << 32);
        if (F.lane == 0) *(f32x4*)(F.SSQ() + (size_t)m * 4) = (f32x4){s, 0.f, 0.f, 0.f};
    }
    const int gt = F.vcu * 512 + F.tid, NGT = F.G * 512;
    for (int e = gt; e < DEPTH * 2 * 4 * 64 * 64; e += NGT) {
        const int i = e & 63, j = (e >> 6) & 63, g = (e >> 12) & 3, mat = (e >> 14) & 1, l = e >> 15;
        const float* w = mat ? F.lru_wx() : F.lru_wa();
        F.GW()[e] = (bf16)f2bf(w[((size_t)(l * 4 + g) * 64 + i) * 64 + j]);
    }
    for (int e = gt; e < DEPTH * 256; e += NGT) {
        const int l = e >> 8, c = e & 255;
        const float h0 = F.hg_lb()[c], h1 = F.hg_lb()[256 + c], mx = fmaxf(h0, h1), e0 = expf(h0 - mx), e1 = expf(h1 - mx);
        F.LB()[e] = l == 0 ? 0.f : e1 / (e0 + e1);
        const float lam = F.lru_lam()[e]; F.SP()[e] = fmaxf(-lam, 0.f) + log1pf(expf(-fabsf(lam)));
    }
}

constexpr int HB = 72;
constexpr int HS = 68, HS1 = 65;
__device__ __forceinline__ int crow(int r, int hi) { return (r & 3) + 8 * (r >> 2) + 4 * hi; }
__device__ __forceinline__ float fast_sigmoid(float x) { return __builtin_amdgcn_rcpf(1.f + __expf(-x)); }
__device__ __forceinline__ void hg_unit(const Frame& F0, int l, int unit, bool fin) {
    const Frame F = F0.fresh();
    const int tid = F.tid, lane = F.lane, wid = F.wave, r32 = lane & 31, hi = lane >> 5;
    const int c = unit & 127, bh = unit >> 7, h = bh & 3, b = bh >> 2;
    const size_t row0 = (size_t)b * T + (size_t)c * 64;
    LAS float* Lb = (LAS float*)F.lds; LAS float* Lx = Lb + 64 * HS1; LAS float* Lo = Lx + 512;
    LAS bf16* Qt = (LAS bf16*)(Lo + 64 * HS); LAS bf16* K0 = Qt + 64 * HB; LAS bf16* K1 = K0 + 32 * HB; LAS bf16* Qe = K1 + 64 * HB;
    LAS bf16* VT = Qe + 64 * HB; LAS bf16* KdT = VT + 64 * HB; LAS bf16* ST = KdT + 64 * HB; LAS bf16* At = ST + 64 * HB;
    const int r = tid >> 3, c8 = (tid & 7) * 8;
    __syncthreads();
    float qs[8], kk[8];
    {
        const bf16* zr = F.Z() + (row0 + r) * DIN + h * 64 + c8;
        float q[8], f[8], v[8];
        unpack8(*(const v4u*)(zr + Z_BQ), q); unpack8(*(const v4u*)(zr + Z_BF), f); unpack8(*(const v4u*)(zr + Z_BI), v);
        const f32x4 lb0 = *(const f32x4*)(F.LB() + l * 256 + h * 64 + c8), lb1 = *(const f32x4*)(F.LB() + l * 256 + h * 64 + c8 + 4);
#pragma unroll
        for (int j = 0; j < 8; ++j) {
            const float lb = j < 4 ? lb0[j & 3] : lb1[j & 3];
            const float e = __expf(-f[j]), rr = __builtin_amdgcn_rcpf(1.f + e);
            const float fg = lb + (1.f - lb) * rr;
            Lb[r * HS1 + c8 + j] = __logf(fmaxf(fg, 1e-37f));
            kk[j] = (1.f - lb) * (e * rr);
            qs[j] = q[j] * fast_sigmoid(q[j]);
            VT[(c8 + j) * HB + r] = (bf16)f2bf(v[j]);
        }
    }
    f32x4 s0 = {0.f, 0.f, 0.f, 0.f}, s1 = {0.f, 0.f, 0.f, 0.f};
    if (fin) { const float* hp = F.HGS() + (size_t)unit * 4096 + r * 64 + c8; s0 = *(const f32x4*)hp; s1 = *(const f32x4*)(hp + 4); }
    __syncthreads();
    {
        const int d = tid & 63, sg = tid >> 6; float run = 0.f;
#pragma unroll
        for (int i = 0; i < 8; ++i) { run += Lb[(sg * 8 + i) * HS1 + d]; Lb[(sg * 8 + i) * HS1 + d] = run; }
        Lx[sg * 64 + d] = run;
        __syncthreads();
        float pre = 0.f;
        for (int s2 = 0; s2 < sg; ++s2) pre += Lx[s2 * 64 + d];
#pragma unroll
        for (int i = 0; i < 8; ++i) Lb[(sg * 8 + i) * HS1 + d] += pre;
    }
    __syncthreads();
    if (!fin) {
#pragma unroll
        for (int j = 0; j < 8; ++j) KdT[(c8 + j) * HB + r] = (bf16)f2bf(kk[j] * __expf(Lb[63 * HS1 + c8 + j] - Lb[r * HS1 + c8 + j]));
        __syncthreads();
        if (wid < 4) {
            const int et = wid >> 1, dt = wid & 1; f32x16 acc;
#pragma unroll
            for (int q_ = 0; q_ < 16; ++q_) acc[q_] = 0.f;
#pragma unroll
            for (int ks = 0; ks < 4; ++ks) { const bf16x8 a = *(const LAS bf16x8*)(VT + (et * 32 + r32) * HB + ks * 16 + hi * 8), bb = *(const LAS bf16x8*)(KdT + (dt * 32 + r32) * HB + ks * 16 + hi * 8);
                acc = __builtin_amdgcn_mfma_f32_32x32x16_bf16(a, bb, acc, 0, 0, 0); }
            float* hp = F.HGS() + (size_t)unit * 4096 + dt * 32 + r32;
#pragma unroll
            for (int q_ = 0; q_ < 16; ++q_) hp[(et * 32 + crow(q_, hi)) * 64] = acc[q_];
        } else if (wid == 4) F.HGD()[unit * 64 + lane] = __expf(Lb[63 * HS1 + lane]);
        return;
    }
    {
        float qt[8], qe[8], k1[8], k0[8];
#pragma unroll
        for (int j = 0; j < 8; ++j) { const float bt = Lb[r * HS1 + c8 + j], b31 = Lb[31 * HS1 + c8 + j], rho = r < 32 ? 0.f : b31;
            qt[j] = qs[j] * __expf(bt - rho); qe[j] = qs[j] * __expf(bt); k1[j] = kk[j] * __expf(fminf(b31 - bt, 80.f)); k0[j] = kk[j] * __expf(fminf(-bt, 80.f)); }
        *(LAS v4u*)(Qt + r * HB + c8) = pack8(qt); *(LAS v4u*)(Qe + r * HB + c8) = pack8(qe); *(LAS v4u*)(K1 + r * HB + c8) = pack8(k1);
        if (r < 32) *(LAS v4u*)(K0 + r * HB + c8) = pack8(k0);
        float sv[8] = {s0[0], s0[1], s0[2], s0[3], s1[0], s1[1], s1[2], s1[3]};
        *(LAS v4u*)(ST + r * HB + c8) = pack8(sv);
    }
    __syncthreads();
    if (wid < 3) {
        const int tb = wid == 0 ? 0 : 32, sb = wid == 2 ? 32 : 0; const LAS bf16* Kp = wid == 0 ? K0 : K1; f32x16 acc;
#pragma unroll
        for (int q_ = 0; q_ < 16; ++q_) acc[q_] = 0.f;
#pragma unroll
        for (int ks = 0; ks < 4; ++ks) { const bf16x8 a = *(const LAS bf16x8*)(Qt + (tb + r32) * HB + ks * 16 + hi * 8), bb = *(const LAS bf16x8*)(Kp + (sb + r32) * HB + ks * 16 + hi * 8);
            acc = __builtin_amdgcn_mfma_f32_32x32x16_bf16(a, bb, acc, 0, 0, 0); }
#pragma unroll
        for (int q_ = 0; q_ < 16; ++q_) { const int tl = crow(q_, hi); const float val = (wid == 1 || r32 <= tl) ? acc[q_] : 0.f; At[(tb + tl) * HB + sb + r32] = (bf16)f2bf(val); }
    }
    __syncthreads();
    if (wid < 4) {
        const int tt = wid >> 1, et = wid & 1; f32x16 acc;
#pragma unroll
        for (int q_ = 0; q_ < 16; ++q_) acc[q_] = 0.f;
#pragma unroll
        for (int ks = 0; ks < 4; ++ks) if (ks < 2 || tt == 1) { const bf16x8 a = *(const LAS bf16x8*)(At + (tt * 32 + r32) * HB + ks * 16 + hi * 8), bb = *(const LAS bf16x8*)(VT + (et * 32 + r32) * HB + ks * 16 + hi * 8);
            acc = __builtin_amdgcn_mfma_f32_32x32x16_bf16(a, bb, acc, 0, 0, 0); }
#pragma unroll
        for (int ks = 0; ks < 4; ++ks) { const bf16x8 a = *(const LAS bf16x8*)(Qe + (tt * 32 + r32) * HB + ks * 16 + hi * 8), bb = *(const LAS bf16x8*)(ST + (et * 32 + r32) * HB + ks * 16 + hi * 8);
            acc = __builtin_amdgcn_mfma_f32_32x32x16_bf16(a, bb, acc, 0, 0, 0); }
#pragma unroll
        for (int q_ = 0; q_ < 16; ++q_) Lo[(tt * 32 + crow(q_, hi)) * HS + et * 32 + r32] = acc[q_];
    }
    __syncthreads();
    {
        const int t = r, e8 = c8; const f32x4 a0 = *(const LAS f32x4*)(Lo + t * HS + e8), a1 = *(const LAS f32x4*)(Lo + t * HS + e8 + 4);
        float acc[8] = {a0[0], a0[1], a0[2], a0[3], a1[0], a1[1], a1[2], a1[3]}; float ss = 0.f;
#pragma unroll
        for (int j = 0; j < 8; ++j) ss += acc[j] * acc[j];
        ss += __shfl_xor(ss, 1); ss += __shfl_xor(ss, 2); ss += __shfl_xor(ss, 4);
        const float rs = rsqrtf(ss * (1.f / 64.f) + EPS);
        float g[8]; unpack8(*(const v4u*)(F.Z() + (row0 + t) * DIN + Z_BG + h * 64 + e8), g);
        const float* nw = F.hg_nw() + l * 64 + e8;
        float o[8];
#pragma unroll
        for (int j = 0; j < 8; ++j) o[j] = acc[j] * rs * nw[j] * (g[j] * fast_sigmoid(g[j]));
        *(v4u*)(F.Y() + (row0 + t) * DM + Y_B + h * 64 + e8) = pack8(o);
    }
}

constexpr int XS = 264;
__device__ __forceinline__ float gelu_tanh(float x) { const float u = 0.7978845608028654f * (x + 0.044715f * x * x * x); return x * __builtin_amdgcn_rcpf(1.f + __expf(-2.f * u)); }
__device__ __forceinline__ void lru_unit(const Frame& F0, int l, int unit, bool fin) {
    const Frame F = F0.fresh();
    const int tid = F.tid, lane = F.lane, wid = F.wave;
    const int c32 = unit & 255, b = unit >> 8, t0 = c32 * 32; const size_t row0 = (size_t)b * T + t0;
    LAS bf16* Lx = (LAS bf16*)F.lds; LAS float* La = (LAS float*)(F.lds + 32 * XS * 2); LAS float* Lu = La + 32 * 256; LAS bf16* Lr = (LAS bf16*)(Lu + 32 * 256);
    const int g = wid >> 1, half = wid & 1, r32 = lane & 31, hi = lane >> 5, chl = half * 32 + r32, ch = g * 64 + chl;
    const int r = tid >> 4, cg = (tid & 15) * 16;
    __syncthreads();
    v4u raw[3];
#pragma unroll
    for (int i = 0; i < 3; ++i) { const int p = tid + i * 512, rr = p >> 5, pc = p & 31, t = t0 - 3 + rr; raw[i] = (v4u){0u, 0u, 0u, 0u};
        if (p < 35 * 32 && t >= 0) raw[i] = *(const v4u*)(F.Z() + ((size_t)b * T + t) * DIN + Z_AX + pc * 8); }
    bf16x8 ba[4], bx[4];
    { const bf16* gwa = F.GW() + ((size_t)((l * 2 + 0) * 4 + g) * 64 + chl) * 64; const bf16* gwx = F.GW() + ((size_t)((l * 2 + 1) * 4 + g) * 64 + chl) * 64;
#pragma unroll
      for (int ks = 0; ks < 4; ++ks) { ba[ks] = *(const bf16x8*)(gwa + ks * 16 + hi * 8); bx[ks] = *(const bf16x8*)(gwx + ks * 16 + hi * 8); } }
    const float bav = F.lru_ba()[l * 256 + ch], bxv = F.lru_bx()[l * 256 + ch], spv = F.SP()[l * 256 + ch];
    LAS float* Lw = (LAS float*)(Lr + 35 * XS);
    float wreg[3];
#pragma unroll
    for (int i = 0; i < 3; ++i) { const int p = tid + i * 512; wreg[i] = 0.f; if (p < 1024) wreg[i] = F.conv_w()[(size_t)l * 1024 + p]; else if (p < 1280) wreg[i] = F.conv_b()[l * 256 + p - 1024]; }
    float cy = 0.f; v4u gy0 = {0u, 0u, 0u, 0u}, gy1 = {0u, 0u, 0u, 0u};
    if (fin) { if (tid < 256) cy = F.LRUC()[unit * 256 + tid]; const bf16* zr = F.Z() + (row0 + r) * DIN + Z_AY + cg; gy0 = *(const v4u*)zr; gy1 = *(const v4u*)(zr + 8); }
#pragma unroll
    for (int i = 0; i < 3; ++i) { const int p = tid + i * 512, rr = p >> 5, pc = p & 31; if (p < 35 * 32) *(LAS v4u*)(Lr + rr * XS + pc * 8) = raw[i]; if (p < 1280) Lw[p] = wreg[i]; }
    __syncthreads();
    {
        float acc[16];
#pragma unroll
        for (int j = 0; j < 16; j += 4) { const f32x4 t4 = *(const LAS f32x4*)(Lw + 1024 + cg + j); acc[j] = t4[0]; acc[j + 1] = t4[1]; acc[j + 2] = t4[2]; acc[j + 3] = t4[3]; }
#pragma unroll
        for (int k = 0; k < 4; ++k) { float x0[8], x1[8]; unpack8(*(const LAS v4u*)(Lr + (r + k) * XS + cg), x0); unpack8(*(const LAS v4u*)(Lr + (r + k) * XS + cg + 8), x1);
#pragma unroll
            for (int j = 0; j < 8; j += 4) { const f32x4 w0 = *(const LAS f32x4*)(Lw + k * 256 + cg + j), w1 = *(const LAS f32x4*)(Lw + k * 256 + cg + 8 + j);
#pragma unroll
                for (int e = 0; e < 4; ++e) { acc[j + e] += w0[e] * x0[j + e]; acc[8 + j + e] += w1[e] * x1[j + e]; } } }
        float a0[8], a1[8];
#pragma unroll
        for (int j = 0; j < 8; ++j) { a0[j] = acc[j]; a1[j] = acc[8 + j]; }
        *(LAS v4u*)(Lx + r * XS + cg) = pack8(a0); *(LAS v4u*)(Lx + r * XS + cg + 8) = pack8(a1);
    }
    __syncthreads();
    {
        f32x16 racc, iacc;
#pragma unroll
        for (int q_ = 0; q_ < 16; ++q_) { racc[q_] = 0.f; iacc[q_] = 0.f; }
#pragma unroll
        for (int ks = 0; ks < 4; ++ks) {
            const bf16x8 a = *(const LAS bf16x8*)(Lx + r32 * XS + g * 64 + ks * 16 + hi * 8);
            racc = __builtin_amdgcn_mfma_f32_32x32x16_bf16(a, ba[ks], racc, 0, 0, 0); iacc = __builtin_amdgcn_mfma_f32_32x32x16_bf16(a, bx[ks], iacc, 0, 0, 0);
        }
#pragma unroll
        for (int q_ = 0; q_ < 16; ++q_) { const int tok = crow(q_, hi);
            const float xcv = bf1(Lx[tok * XS + ch]);
            const float rg = fast_sigmoid(racc[q_] + bav), ig = fast_sigmoid(iacc[q_] + bxv);
            const float la = -8.f * rg * spv, av = __expf(la), x2 = 2.f * la;
            const float em = x2 > -0.3f ? -x2 * (1.f + x2 * 0.5f * (1.f + x2 * (1.f / 3.f) * (1.f + x2 * 0.25f * (1.f + x2 * 0.2f)))) : 1.f - __expf(x2);
            La[tok * 256 + ch] = av; Lu[tok * 256 + ch] = sqrtf(em) * ig * xcv; }
    }
    __syncthreads();
    if (tid < 256) {
        float hc = cy, P = 1.f;
#pragma unroll 8
        for (int t = 0; t < 32; ++t) { const float av = La[t * 256 + tid], uv = Lu[t * 256 + tid]; hc = av * hc + uv; P *= av; if (fin) Lu[t * 256 + tid] = hc; }
        if (!fin) { F.LRUA()[unit * 256 + tid] = P; F.LRUU()[unit * 256 + tid] = hc; }
    }
    if (!fin) return;
    __syncthreads();
    {
        float g0[8], g1[8]; unpack8(gy0, g0); unpack8(gy1, g1);
        float v0[8], v1[8], ss = 0.f;
#pragma unroll
        for (int j = 0; j < 8; ++j) { v0[j] = Lu[r * 256 + cg + j] * gelu_tanh(g0[j]); v1[j] = Lu[r * 256 + cg + 8 + j] * gelu_tanh(g1[j]); ss += v0[j] * v0[j] + v1[j] * v1[j]; }
        ss += __shfl_xor(ss, 1); ss += __shfl_xor(ss, 2); ss += __shfl_xor(ss, 4); ss += __shfl_xor(ss, 8);
        const float rs = rsqrtf(ss * (1.f / 256.f) + EPS);
#pragma unroll
        for (int j = 0; j < 8; ++j) { v0[j] *= rs; v1[j] *= rs; }
        bf16* yr = F.Y() + (row0 + r) * DM + Y_A + cg; *(v4u*)yr = pack8(v0); *(v4u*)(yr + 8) = pack8(v1);
    }
}

__device__ __forceinline__ void kmean_unit(const Frame& F0, int unit) {
    const Frame F = F0.fresh();
    const int q = unit & 3, n = (unit >> 2) & 31, b = unit >> 7, rg = F.tid >> 6, ch = F.tid & 63;
    LAS float* part = (LAS float*)F.lds;
    __syncthreads();
    const bf16* zp = F.Z() + ((size_t)b * T + (size_t)n * 256 + q * 64 + rg * 8) * DIN + Z_CK + ch * 8; float s[8];
#pragma unroll
    for (int j = 0; j < 8; ++j) s[j] = 0.f;
#pragma unroll
    for (int r = 0; r < 8; ++r) { float t8[8]; unpack8(*(const v4u*)(zp + (size_t)r * DIN), t8);
#pragma unroll
        for (int j = 0; j < 8; ++j) s[j] += t8[j]; }
    *(LAS f32x4*)(part + rg * 512 + ch * 8) = (f32x4){s[0], s[1], s[2], s[3]}; *(LAS f32x4*)(part + rg * 512 + ch * 8 + 4) = (f32x4){s[4], s[5], s[6], s[7]};
    __syncthreads();
    float t = 0.f;
#pragma unroll
    for (int g = 0; g < 8; ++g) t += part[g * 512 + F.tid];
    F.KMP()[(size_t)unit * 512 + F.tid] = t;
}
__device__ __forceinline__ void select_unit(const Frame& F0, int item) {
    const Frame F = F0.fresh();
    const int hp = item & 3, j = (item >> 2) & 31, b = item >> 7, hsel = F.tid >> 8, h = hp * 2 + hsel, tok = F.tid & 255;
    LAS float* km = (LAS float*)F.lds;
    __syncthreads();
#pragma unroll
    for (int i = 0; i < 8; ++i) { const int e = i * 512 + F.tid, hs = e >> 11, n = (e >> 6) & 31, dd = e & 63; const float* kp = F.KMP() + ((size_t)(b * 32 + n) * 4) * 512 + (hp * 2 + hs) * 64 + dd;
        km[e] = ((kp[0] + kp[512]) + (kp[1024] + kp[1536])) * (1.f / 256.f); }
    __syncthreads();
    const size_t row = (size_t)b * T + (size_t)j * 256 + tok;
    float q[64];
#pragma unroll
    for (int i = 0; i < 8; ++i) { float t8[8]; unpack8(*(const v4u*)(F.Z() + row * DIN + Z_CQ + h * 64 + i * 8), t8);
#pragma unroll
        for (int e = 0; e < 8; ++e) q[i * 8 + e] = t8[e]; }
    float v1 = -INFINITY, v2 = -INFINITY, v3 = -INFINITY; int i1 = -1, i2 = -1, i3 = -1;
    for (int n = 0; n < j; ++n) { const LAS float* kp = km + (hsel * 32 + n) * 64; float g = 0.f;
#pragma unroll
        for (int d = 0; d < 64; d += 4) { const f32x4 kv = *(const LAS f32x4*)(kp + d); g += q[d] * kv[0] + q[d + 1] * kv[1] + q[d + 2] * kv[2] + q[d + 3] * kv[3]; }
        if (g > v1) { v3 = v2; i3 = i2; v2 = v1; i2 = i1; v1 = g; i1 = n; }
        else if (g > v2) { v3 = v2; i3 = i2; v2 = g; i2 = n; }
        else if (g > v3) { v3 = g; i3 = n; } }
    unsigned msk = 0u; if (i1 >= 0) msk |= 1u << i1; if (i2 >= 0) msk |= 1u << i2; if (i3 >= 0) msk |= 1u << i3;
    F.SEL()[row * 8 + h] = msk;
    LAS unsigned* wc = (LAS unsigned*)(F.lds + 16384);
    const unsigned long long lt = (1ull << F.lane) - 1ull; int p1 = 0, p2 = 0, p3 = 0;
    for (int n = 0; n < j; ++n) { const unsigned long long bl = __ballot((msk >> n) & 1u); const int pc = __popcll(bl & lt);
        if (n == i1) p1 = pc; if (n == i2) p2 = pc; if (n == i3) p3 = pc; if (F.lane == 0) wc[F.wave * 32 + n] = (unsigned)__popcll(bl); }
    __syncthreads();
    { const int w0 = F.wave & 4; unsigned char* lp = F.LIST() + ((size_t)(b * 8 + h) * 32) * 32 * 256 + (size_t)j * 256;
#define SEL_PUT(ik, pk) if (ik >= 0) { int base = 0; for (int w = w0; w < F.wave; ++w) base += (int)wc[w * 32 + ik]; lp[(size_t)ik * 32 * 256 + base + pk] = (unsigned char)tok; }
      SEL_PUT(i1, p1) SEL_PUT(i2, p2) SEL_PUT(i3, p3)
#undef SEL_PUT
    }
    if (F.tid < 64) { const int hs = F.tid >> 5, n = F.tid & 31; if (n < j) F.CNT()[((size_t)(b * 8 + hp * 2 + hs) * 32 + n) * 32 + j] = (wc[(hs * 4) * 32 + n] + wc[(hs * 4 + 1) * 32 + n]) + (wc[(hs * 4 + 2) * 32 + n] + wc[(hs * 4 + 3) * 32 + n]); }
}

__device__ __forceinline__ void hg_scan_item(const Frame& F0, int item) {
    const Frame F = F0.fresh();
    const int el = F.tid & 63, grp = F.tid >> 6, e = item * 64 + el, seq = e >> 12, de = e & 4095, dd = de & 63;
    LAS float* gS = (LAS float*)F.lds; LAS float* gD = gS + 512;
    __syncthreads();
    float Hc[16], Dc[16]; float* hp = F.HGS() + (size_t)(seq * 128 + grp * 16) * 4096 + de; const float* dp = F.HGD() + (seq * 128 + grp * 16) * 64 + dd;
#pragma unroll
    for (int i = 0; i < 16; ++i) { Hc[i] = hp[(size_t)i * 4096]; Dc[i] = dp[i * 64]; }
    float s = 0.f, pd = 1.f;
#pragma unroll
    for (int i = 0; i < 16; ++i) { s = Dc[i] * s + Hc[i]; pd *= Dc[i]; }
    gS[grp * 64 + el] = s; gD[grp * 64 + el] = pd;
    __syncthreads();
    float cy = 0.f;
    for (int g = 0; g < grp; ++g) cy = gD[g * 64 + el] * cy + gS[g * 64 + el];
#pragma unroll
    for (int i = 0; i < 16; ++i) { hp[(size_t)i * 4096] = cy; cy = Dc[i] * cy + Hc[i]; }
}
__device__ __forceinline__ void lru_scan_item(const Frame& F0, int item) {
    const Frame F = F0.fresh();
    const int sl = F.tid & 31, grp = F.tid >> 5, sidx = item * 32 + sl, b = sidx >> 8, ch = sidx & 255;
    LAS float* gA = (LAS float*)F.lds; LAS float* gU = gA + 512;
    __syncthreads();
    float A[16], U[16]; const int u0 = (b * 256 + grp * 16) * 256 + ch;
#pragma unroll
    for (int i = 0; i < 16; ++i) { A[i] = F.LRUA()[u0 + i * 256]; U[i] = F.LRUU()[u0 + i * 256]; }
    float pa = 1.f, pu = 0.f;
#pragma unroll
    for (int i = 0; i < 16; ++i) { pu = A[i] * pu + U[i]; pa *= A[i]; }
    gA[grp * 32 + sl] = pa; gU[grp * 32 + sl] = pu;
    __syncthreads();
    float cy = 0.f;
    for (int g = 0; g < grp; ++g) cy = gA[g * 32 + sl] * cy + gU[g * 32 + sl];
#pragma unroll
    for (int i = 0; i < 16; ++i) { F.LRUC()[u0 + i * 256] = cy; cy = A[i] * cy + U[i]; }
}

namespace moba {
typedef LAS const char* lds_cptr;
typedef short v4i16_t __attribute__((ext_vector_type(4)));
constexpr int SLOTB = 8192, LDS_K = 0, LDS_V = 2 * SLOTB, LDS_WS = 4 * SLOTB, LDS_OST = LDS_WS + NWAVES * 256, LDS_FLAG = LDS_OST + NWAVES * 4096;
__device__ __forceinline__ void glds16(const void* gsrc, unsigned lds_dst) { unsigned keep;
    asm volatile("s_mov_b32 %0, m0\n\ts_mov_b32 m0, %2\n\ts_nop 0\n\tglobal_load_lds_dwordx4 %1, off\n\ts_mov_b32 m0, %0" : "=&s"(keep) : "v"(gsrc), "s"(lds_dst) : "memory"); }
typedef float f32x2_t __attribute__((ext_vector_type(2))); typedef __bf16 bf16x2_t __attribute__((ext_vector_type(2)));
__device__ __forceinline__ unsigned cvtpk_s(float lo, float hi) { f32x2_t v = {lo, hi}; bf16x2_t b = __builtin_convertvector(v, bf16x2_t); return __builtin_bit_cast(unsigned, b); }
#define MX3(a, b, c) __builtin_fmaxf(__builtin_fmaxf((a), (b)), (c))
__device__ __forceinline__ float rowmax(const f32x16& p0, const f32x16& p1) {
    float a = MX3(p0[0], p0[1], p1[0]), b = MX3(p0[2], p0[3], p1[1]); a = MX3(a, p1[2], p1[3]);
#pragma unroll
    for (int r = 4; r < 16; r += 4) { a = MX3(a, p0[r], p0[r + 1]); b = MX3(b, p0[r + 2], p0[r + 3]); a = MX3(a, p1[r], p1[r + 1]); b = MX3(b, p1[r + 2], p1[r + 3]); }
    float m = __builtin_fmaxf(a, b); auto rr = __builtin_amdgcn_permlane32_swap(__float_as_uint(m), __float_as_uint(m), false, false);
    return __builtin_fmaxf(__uint_as_float(rr[0]), __uint_as_float(rr[1])); }
#undef MX3
__device__ __forceinline__ void qkt(f32x16& p0, f32x16& p1, lds_cptr kb, const bf16x8* qr, const f32x16& c0) {
#pragma unroll
    for (int d0 = 0; d0 < 4; ++d0) {
        const bf16x8 b0 = *(const LAS bf16x8*)(kb + d0 * 2048), b1 = *(const LAS bf16x8*)(kb + d0 * 2048 + 512);
        if (d0 == 0) { p0 = __builtin_amdgcn_mfma_f32_32x32x16_bf16(b0, qr[0], c0, 0, 0, 0); p1 = __builtin_amdgcn_mfma_f32_32x32x16_bf16(b1, qr[0], c0, 0, 0, 0); }
        else { p0 = __builtin_amdgcn_mfma_f32_32x32x16_bf16(b0, qr[d0], p0, 0, 0, 0); p1 = __builtin_amdgcn_mfma_f32_32x32x16_bf16(b1, qr[d0], p1, 0, 0, 0); } }
}
__device__ __forceinline__ void pv(f32x16* o, int vb, bf16x8 pa0, bf16x8 pa1, bf16x8 pa2, bf16x8 pa3) {
#pragma unroll
    for (int d0 = 0; d0 < 2; ++d0) { s16x4 lo[4], hi[4];
#pragma unroll
        for (int ks = 0; ks < 4; ++ks) {
            asm volatile("ds_read_b64_tr_b16 %0,%1 offset:%c2" : "=&v"(lo[ks]) : "v"(vb), "i"(d0 * 4096 + ks * 1024) : "memory");
            asm volatile("ds_read_b64_tr_b16 %0,%1 offset:%c2" : "=&v"(hi[ks]) : "v"(vb), "i"(d0 * 4096 + ks * 1024 + 512) : "memory"); }
        asm volatile("s_waitcnt lgkmcnt(0)" ::: "memory"); __builtin_amdgcn_sched_barrier(0);
#define PK(k) (bf16x8){lo[k][0], lo[k][1], lo[k][2], lo[k][3], hi[k][0], hi[k][1], hi[k][2], hi[k][3]}
        o[d0] = __builtin_amdgcn_mfma_f32_32x32x16_bf16(pa0, PK(0), o[d0], 0, 0, 0);
        o[d0] = __builtin_amdgcn_mfma_f32_32x32x16_bf16(pa1, PK(1), o[d0], 0, 0, 0);
        o[d0] = __builtin_amdgcn_mfma_f32_32x32x16_bf16(pa2, PK(2), o[d0], 0, 0, 0);
        o[d0] = __builtin_amdgcn_mfma_f32_32x32x16_bf16(pa3, PK(3), o[d0], 0, 0, 0);
#undef PK
    }
}
__device__ __forceinline__ void attn_unit(const Frame& F, int b, int h, int jb) {
    LAS char* shm = (LAS char*)F.lds;
    const int lane = F.lane, r32 = lane & 31, hi = lane >> 5, wid = F.wave;
    const long rowbase = (long)b * T; const int q0 = jb * 256;
    const bf16* Qw = F.Z() + (rowbase + q0 + wid * 32) * DIN + Z_CQ + h * 64;
    const bf16* Kh = F.Z() + rowbase * DIN + Z_CK + h * 64; const bf16* Vh = F.Z() + rowbase * DIN + Z_CV + h * 64;
    const unsigned lds0 = (unsigned)(uintptr_t)shm;
    LAS float* wsf = (LAS float*)(shm + LDS_WS) + wid * 64;
    const bf16* ksrc = Kh + (long)lane * DIN + wid * 8;
    const bf16* vsrc = Vh + (long)(16 * (wid & 3) + (lane >> 2)) * DIN + (wid >> 2) * 32 + (lane & 3) * 8;
    const unsigned kdst = lds0 + LDS_K + wid * 1024, vdst = lds0 + LDS_V + wid * 1024;
#define DMA_K(pt, slot) glds16(ksrc + (long)(pt) * 64 * DIN, (unsigned)__builtin_amdgcn_readfirstlane(kdst + (slot)))
#define DMA_V(pt, slot) glds16(vsrc + (long)(pt) * 64 * DIN, (unsigned)__builtin_amdgcn_readfirstlane(vdst + (slot)))
    const int vb0 = (int)(lds0 + LDS_V) + ((lane >> 4) & 1) * 32 + (lane & 3) * 8 + (4 * hi + ((lane & 15) >> 2)) * 64;
    const lds_cptr kp0 = (lds_cptr)shm + LDS_K + hi * 1024 + r32 * 16;
    bf16x8 qr[4];
#pragma unroll
    for (int d0 = 0; d0 < 4; ++d0) qr[d0] = *(const bf16x8*)(Qw + (long)r32 * DIN + d0 * 16 + hi * 8);
    const int qrel = wid * 32 + r32;
    const unsigned selm = F.SEL()[(size_t)(rowbase + q0 + qrel) * 8 + h];
    unsigned wor = selm;
#pragma unroll
    for (int o_ = 1; o_ < 32; o_ <<= 1) wor |= (unsigned)__shfl_xor((int)wor, o_);
    LAS unsigned* flg = (LAS unsigned*)(shm + LDS_FLAG);
    __syncthreads();
    if (lane == 0) flg[wid] = wor;
    __syncthreads();
    unsigned rem = 0u;
#pragma unroll
    for (int w = 0; w < NWAVES; ++w) rem |= flg[w];
    rem = (unsigned)__builtin_amdgcn_readfirstlane((int)rem);
    const float beta = exp2f(-(float)(h + 1)) * LOG2E;
    float mhat = 0.f, l_reg = 0.f; f32x16 o[2];
#pragma unroll
    for (int r = 0; r < 16; ++r) { o[0][r] = 0.f; o[1][r] = 0.f; }
    int blk = jb, ti = 0, slot = 0; bool first = true;
    DMA_K(4 * blk, 0); DMA_V(4 * blk, 0);
    for (;;) {
        int nblk = blk, nti = ti + 1; bool has_next = true;
        if (nti == 4) { if (rem) { nblk = __builtin_ctz(rem); rem &= rem - 1u; nti = 0; } else has_next = false; }
        asm volatile("s_waitcnt vmcnt(0) lgkmcnt(0)\n\ts_barrier" ::: "memory");
        if (has_next) { DMA_K(4 * nblk + nti, (slot ^ 1) * SLOTB); DMA_V(4 * nblk + nti, (slot ^ 1) * SLOTB); }
        f32x16 negm;
#pragma unroll
        for (int r = 0; r < 16; ++r) negm[r] = -mhat;
        f32x16 p0, p1; qkt(p0, p1, kp0 + slot * SLOTB, qr, negm);
        const int pt = 4 * blk + ti;
        if (blk == jb) {
            const int kb = 64 * ti + 4 * hi;
#pragma unroll
            for (int r = 0; r < 16; ++r) { const int kv = kb + (r & 3) + 8 * (r >> 2); if (kv > qrel) p0[r] = -INFINITY; if (kv + 32 > qrel) p1[r] = -INFINITY; }
        } else if (!((selm >> blk) & 1u)) {
#pragma unroll
            for (int r = 0; r < 16; ++r) { p0[r] = -INFINITY; p1[r] = -INFINITY; }
        }
        const float ab = beta * (float)(64 * pt + 4 * hi - (q0 + qrel));
#pragma unroll
        for (int r = 0; r < 16; ++r) { const float cr = (float)((r & 3) + 8 * (r >> 2)); p0[r] += ab + beta * cr; p1[r] += ab + beta * (cr + 32.f); }
        const float rm = rowmax(p0, p1);
        bool resc = false;
        if (first || __any(rm > 0.f)) {
            const float dl = first ? rm : fmaxf(rm, 0.f); mhat += dl;
#pragma unroll
            for (int r = 0; r < 16; ++r) { p0[r] -= dl; p1[r] -= dl; }
            if (!first) { const float f = __builtin_amdgcn_exp2f(-dl); l_reg *= f; if (hi == 0) wsf[r32] = f; resc = true; }
        }
        if (resc) {
#pragma unroll
            for (int d_ = 0; d_ < 2; ++d_)
#pragma unroll
                for (int r = 0; r < 16; ++r) o[d_][r] *= wsf[crow(r, hi)];
        }
        float sacc = 0.f;
#pragma unroll
        for (int r = 0; r < 16; ++r) { p0[r] = __builtin_amdgcn_exp2f(p0[r]); p1[r] = __builtin_amdgcn_exp2f(p1[r]); sacc += p0[r] + p1[r]; }
        l_reg += sacc;
        v4u pw0, pw1, pw2, pw3;
#define PKW(P, B) cvtpk_s(P[B], P[B + 1])
        pw0 = (v4u){PKW(p0, 0), PKW(p0, 2), PKW(p0, 4), PKW(p0, 6)}; pw1 = (v4u){PKW(p0, 8), PKW(p0, 10), PKW(p0, 12), PKW(p0, 14)};
        pw2 = (v4u){PKW(p1, 0), PKW(p1, 2), PKW(p1, 4), PKW(p1, 6)}; pw3 = (v4u){PKW(p1, 8), PKW(p1, 10), PKW(p1, 12), PKW(p1, 14)};
#undef PKW
        __builtin_amdgcn_sched_barrier(0);
        pv(o, vb0 + slot * SLOTB, __builtin_bit_cast(bf16x8, pw0), __builtin_bit_cast(bf16x8, pw1), __builtin_bit_cast(bf16x8, pw2), __builtin_bit_cast(bf16x8, pw3));
        first = false;
        if (!has_next) break;
        blk = nblk; ti = nti; slot ^= 1;
    }
#undef DMA_K
#undef DMA_V
    { auto rr = __builtin_amdgcn_permlane32_swap(__float_as_uint(l_reg), __float_as_uint(l_reg), false, false); l_reg = __uint_as_float(rr[0]) + __uint_as_float(rr[1]); }
    if (hi == 0) wsf[32 + r32] = l_reg;
    float rli[16];
#pragma unroll
    for (int r = 0; r < 16; ++r) rli[r] = 1.f / wsf[32 + crow(r, hi)];
    LAS bf16* stg = (LAS bf16*)(shm + LDS_OST) + wid * 2048;
#pragma unroll
    for (int r = 0; r < 16; ++r) { const int orow = crow(r, hi);
#pragma unroll
        for (int d0 = 0; d0 < 2; ++d0) stg[orow * 64 + d0 * 32 + r32] = (bf16)f2bf(o[d0][r] * rli[r]); }
    bf16* Ow = F.Y() + (rowbase + q0 + wid * 32) * DM + Y_C + h * 64;
#pragma unroll
    for (int i = 0; i < 4; ++i) { const int row = i * 8 + (lane >> 3), ch = lane & 7; const v4u v = *(const LAS v4u*)(stg + row * 64 + ch * 8); *(v4u*)(Ow + (long)row * DM + ch * 8) = v; }
}

constexpr int F_K = 0, F_V = 3 * SLOTB, F_WS = 6 * SLOTB, F_OST = F_WS + NWAVES * 256, F_TAB = F_OST + NWAVES * 4096, F_FLAG = F_TAB + 256;
#define SBAR() __builtin_amdgcn_sched_barrier(0)
#define WAIT_BAR(N) asm volatile("s_waitcnt vmcnt(" #N ") lgkmcnt(0)\n\ts_barrier":::"memory")
__device__ __forceinline__ void kload8(bf16x8* kf, lds_cptr kp) {
    kf[0] = *(const LAS bf16x8*)(kp);        kf[1] = *(const LAS bf16x8*)(kp + 512);
    kf[2] = *(const LAS bf16x8*)(kp + 2048); kf[3] = *(const LAS bf16x8*)(kp + 2560);
    kf[4] = *(const LAS bf16x8*)(kp + 4096); kf[5] = *(const LAS bf16x8*)(kp + 4608);
    kf[6] = *(const LAS bf16x8*)(kp + 6144); kf[7] = *(const LAS bf16x8*)(kp + 6656);
}
__device__ __forceinline__ void kload2(bf16x8* kf, lds_cptr kp, int j) { kf[2 * j] = *(const LAS bf16x8*)(kp + j * 2048); kf[2 * j + 1] = *(const LAS bf16x8*)(kp + j * 2048 + 512); }
__device__ __forceinline__ s16x4 vtr(lds_cptr p) { return __builtin_bit_cast(s16x4, __builtin_amdgcn_ds_read_tr16_b64_v4i16((LAS v4i16_t*)p)); }
__device__ __forceinline__ void glds16s(const void* sbase, unsigned voff, unsigned lds_dst) { unsigned keep;
    asm volatile("s_mov_b32 %0, m0\n\ts_mov_b32 m0, %3\n\ts_nop 0\n\tglobal_load_lds_dwordx4 %1, %2\n\ts_mov_b32 m0, %0" : "=&s"(keep) : "v"(voff), "s"(sbase), "s"(lds_dst) : "memory"); }
template <int THRL> __device__ __forceinline__ void attn_unit_fast(const Frame& F0, int b, int h, int jb) {
    const Frame F = F0.fresh();
    LAS char* shm = (LAS char*)F.lds;
    const int lane = F.lane, r32 = lane & 31, hi = lane >> 5, wid = F.wave;
    const long rowbase = (long)b * T; const int q0 = jb * 256;
    const bf16* Qw = F.Z() + (rowbase + q0 + wid * 32) * DIN + Z_CQ + h * 64;
    const bf16* Kh = F.Z() + rowbase * DIN + Z_CK + h * 64; const bf16* Vh = F.Z() + rowbase * DIN + Z_CV + h * 64;
    const unsigned lds0 = (unsigned)(uintptr_t)shm;
    LAS float* wsf = (LAS float*)(shm + F_WS) + wid * 64;
    const unsigned koff = (unsigned)(lane * DIN + wid * 8) * 2u;
    const unsigned voff = (unsigned)((16 * (wid & 3) + (lane >> 2)) * DIN + (wid >> 2) * 32 + (lane & 3) * 8) * 2u;
    const unsigned kdst = lds0 + F_K + wid * 1024, vdst = lds0 + F_V + wid * 1024;
#define DMA_K(pt, slot) glds16s(Kh + (long)(pt) * 64 * DIN, koff, (unsigned)__builtin_amdgcn_readfirstlane(kdst + (slot)))
#define DMA_V(pt, slot) glds16s(Vh + (long)(pt) * 64 * DIN, voff, (unsigned)__builtin_amdgcn_readfirstlane(vdst + (slot)))
    const int vb0 = (int)(lds0 + F_V) + ((lane >> 4) & 1) * 32 + (lane & 3) * 8 + (4 * hi + ((lane & 15) >> 2)) * 64;
    const lds_cptr shm3 = (lds_cptr)shm; const lds_cptr kp0 = shm3 + F_K + hi * 1024 + r32 * 16; const lds_cptr vp0 = shm3 + F_V + ((lane >> 4) & 1) * 32 + (lane & 3) * 8 + (4 * hi + ((lane & 15) >> 2)) * 64;
    const int qrel = wid * 32 + r32;
    const unsigned selm = F.SEL()[(size_t)(rowbase + q0 + qrel) * 8 + h];
    unsigned wor = selm;
#pragma unroll
    for (int o_ = 1; o_ < 32; o_ <<= 1) wor |= (unsigned)__shfl_xor((int)wor, o_);
    LAS unsigned* flg = (LAS unsigned*)(shm + F_FLAG); LAS int* tab = (LAS int*)(shm + F_TAB);
    __syncthreads();
    if (lane == 0) flg[wid] = wor;
    __syncthreads();
    unsigned rem = 0u;
#pragma unroll
    for (int w = 0; w < NWAVES; ++w) rem |= flg[w];
    rem = (unsigned)__builtin_amdgcn_readfirstlane((int)rem);
    if (F.tid == 0) tab[0] = jb;
    if (F.tid >= 1 && F.tid <= 32 && ((rem >> (F.tid - 1)) & 1u)) tab[1 + __builtin_popcount(rem & ((1u << (F.tid - 1)) - 1u))] = F.tid - 1;
    __syncthreads();
    const int NT = 4 * (1 + __builtin_popcount(rem));
#define PT(t) (4 * __builtin_amdgcn_readfirstlane(tab[((t) >> 2) & 63]) + ((t) & 3))
    DMA_K(PT(0), 0); DMA_V(PT(0), 0); DMA_K(PT(1), SLOTB);
    bf16x8 qr[4];
#pragma unroll
    for (int d0 = 0; d0 < 4; ++d0) qr[d0] = *(const bf16x8*)(Qw + (long)r32 * DIN + d0 * 16 + hi * 8);
    const float beta = __uint_as_float((unsigned)__builtin_amdgcn_readfirstlane((int)__float_as_uint(exp2f(-(float)(h + 1)) * LOG2E)));
    const float qoff = (float)(4 * hi - (q0 + qrel));
    float mhat = 0.f, l_reg = 0.f; f32x16 o[2];
#pragma unroll
    for (int r = 0; r < 16; ++r) { o[0][r] = 0.f; o[1][r] = 0.f; }
#define INITC(C0, C1, t) do { const int bc_ = __builtin_amdgcn_readfirstlane(tab[((t) >> 2) & 63]); const bool on_ = (bc_ == jb) || ((selm >> bc_) & 1u); \
        const float ct_ = on_ ? __builtin_fmaf(beta, (float)(64 * (4 * bc_ + ((t) & 3))) + qoff, -mhat) : -1e30f; \
        _Pragma("unroll") for (int r = 0; r < 16; ++r) { const float cr_ = (float)((r & 3) + 8 * (r >> 2)); C0[r] = __builtin_fmaf(beta, cr_, ct_); C1[r] = __builtin_fmaf(beta, cr_ + 32.f, ct_); } } while (0)
#define CMASK(P0, P1, t) do { if ((t) < 4) { const int kb_ = 64 * (t) + 4 * hi; \
        _Pragma("unroll") for (int r = 0; r < 16; ++r) { const int kv_ = kb_ + (r & 3) + 8 * (r >> 2); if (kv_ > qrel) P0[r] = -INFINITY; if (kv_ + 32 > qrel) P1[r] = -INFINITY; } } } while (0)
    bool resc = false;
#define RESC() do { if (resc) { asm volatile("s_waitcnt lgkmcnt(0)" ::: "memory"); \
        _Pragma("unroll") for (int d_ = 0; d_ < 2; ++d_) _Pragma("unroll") for (int r = 0; r < 16; ++r) o[d_][r] *= wsf[crow(r, hi)]; } } while (0)
    f32x16 pA0, pA1, pB0, pB1;
    int sl_prev = 0, sl_cur = 0, sl_next = SLOTB;
#define ROT() do { sl_prev = sl_cur; sl_cur = sl_next; sl_next = (sl_next == 2 * SLOTB) ? 0 : sl_next + SLOTB; } while (0)
    DMA_K(PT(2), 2 * SLOTB);
    WAIT_BAR(3);
    INITC(pA0, pA1, 0);
    { f32x16 c0 = pA0, c1 = pA1;
#pragma unroll
      for (int d0 = 0; d0 < 4; ++d0) { const bf16x8 b0 = *(const LAS bf16x8*)(kp0 + d0 * 2048), b1 = *(const LAS bf16x8*)(kp0 + d0 * 2048 + 512);
          c0 = __builtin_amdgcn_mfma_f32_32x32x16_bf16(b0, qr[d0], c0, 0, 0, 0); c1 = __builtin_amdgcn_mfma_f32_32x32x16_bf16(b1, qr[d0], c1, 0, 0, 0); }
      pA0 = c0; pA1 = c1; }
    CMASK(pA0, pA1, 0);
    { const float dl = rowmax(pA0, pA1); mhat += dl;
#pragma unroll
      for (int r = 0; r < 16; ++r) { pA0[r] = __builtin_amdgcn_exp2f(pA0[r] - dl); pA1[r] = __builtin_amdgcn_exp2f(pA1[r] - dl); } }
    WAIT_BAR(0);
    DMA_K(PT(3), 0); DMA_V(PT(1), SLOTB);
    ROT();
    bf16x8 kf[8];
    kload8(kf, kp0 + sl_cur);
    WAIT_BAR(2);
  s16x4 vlo[8],vhi[8]; v4u pw0,pw1,pw2,pw3;
  #define PKW(P,B) cvtpk_s(P[B],P[B+1])
  #define PAF(k) __builtin_bit_cast(bf16x8,pw##k)
  #define VFR(i) (bf16x8){vlo[i][0],vlo[i][1],vlo[i][2],vlo[i][3],vhi[i][0],vhi[i][1],vhi[i][2],vhi[i][3]}
  #define PIN(x) asm volatile("":"+v"(x))
  #define MX3(a,b,c) __builtin_fmaxf(__builtin_fmaxf((a),(b)),(c))
  #define GAPA(MF,A0,A1,A2,A3,W0,W1,PW) do{ MF; sacc+=A0; sacc+=A1; sacc+=A2; sacc+=A3; PIN(sacc); W0; W1; PIN(PW); SBAR(); }while(0)
  #define EX(v) __builtin_amdgcn_exp2f(v)
  #define GAPB(MF,X,B) do{ MF; X[B]=EX(X[B]); X[B+1]=EX(X[B+1]); X[B+2]=EX(X[B+2]); X[B+3]=EX(X[B+3]); PIN(X); SBAR(); }while(0)
  #define VRD(i) do{ vlo[i]=vtr(vp_+(((i)>>2)*4096+((i)&3)*1024)); vhi[i]=vtr(vp_+(((i)>>2)*4096+((i)&3)*1024+512)); }while(0)
  #define KRD(G,j) do{ if(G){ kload2(kf,kp0+sl_next,j); SBAR(); } }while(0)
  #define STEP(C0,C1,P0,P1,t,GK,GV,GL) do{ INITC(C0,C1,t); SBAR(); \
    const lds_cptr vp_=vp0+sl_prev; \
    VRD(0); SBAR(); float sacc=(P0[0]+P0[1]); \
    GAPA(C0=__builtin_amdgcn_mfma_f32_32x32x16_bf16(kf[0],qr[0],C0,0,0,0), P0[2],P0[3],P0[4],P0[5],     pw0[0]=PKW(P0,0), pw0[1]=PKW(P0,2), pw0); \
    VRD(4); SBAR(); GAPA(C1=__builtin_amdgcn_mfma_f32_32x32x16_bf16(kf[1],qr[0],C1,0,0,0), P0[6],P0[7],P0[8],P0[9],     pw0[2]=PKW(P0,4), pw0[3]=PKW(P0,6), pw0); \
    VRD(1); SBAR(); GAPA(C0=__builtin_amdgcn_mfma_f32_32x32x16_bf16(kf[2],qr[1],C0,0,0,0),   P0[10],P0[11],P0[12],P0[13], pw1[0]=PKW(P0,8), pw1[1]=PKW(P0,10), pw1); \
    VRD(5); SBAR(); GAPA(C1=__builtin_amdgcn_mfma_f32_32x32x16_bf16(kf[3],qr[1],C1,0,0,0),   P0[14],P0[15],P1[0],P1[1],   pw1[2]=PKW(P0,12),pw1[3]=PKW(P0,14), pw1); \
    VRD(2); SBAR(); GAPA(C0=__builtin_amdgcn_mfma_f32_32x32x16_bf16(kf[4],qr[2],C0,0,0,0),   P1[2],P1[3],P1[4],P1[5],     pw2[0]=PKW(P1,0), pw2[1]=PKW(P1,2), pw2); \
    VRD(6); SBAR(); GAPA(C1=__builtin_amdgcn_mfma_f32_32x32x16_bf16(kf[5],qr[2],C1,0,0,0),   P1[6],P1[7],P1[8],P1[9],     pw2[2]=PKW(P1,4), pw2[3]=PKW(P1,6), pw2); \
    VRD(3); SBAR(); GAPA(C0=__builtin_amdgcn_mfma_f32_32x32x16_bf16(kf[6],qr[3],C0,0,0,0),   P1[10],P1[11],P1[12],P1[13], pw3[0]=PKW(P1,8), pw3[1]=PKW(P1,10), pw3); \
    VRD(7); SBAR(); GAPA(C1=__builtin_amdgcn_mfma_f32_32x32x16_bf16(kf[7],qr[3],C1,0,0,0),   P1[14],P1[15],0.f,0.f,       pw3[2]=PKW(P1,12),pw3[3]=PKW(P1,14), pw3); \
    l_reg+=sacc; \
    if(GK){DMA_K(PT((t)+3),sl_cur);} if(GV){DMA_V(PT((t)+1),sl_next);} \
    CMASK(C0,C1,t); \
    { float a=MX3(C0[0],C0[1],C1[0]),b=MX3(C0[2],C0[3],C1[1]); a=MX3(a,C1[2],C1[3]); \
      _Pragma("unroll") for(int r=4;r<16;r+=4){a=MX3(a,C0[r],C0[r+1]);b=MX3(b,C0[r+2],C0[r+3]);a=MX3(a,C1[r],C1[r+1]);b=MX3(b,C1[r+2],C1[r+3]);} \
      float rm=__builtin_fmaxf(a,b); { auto rr=__builtin_amdgcn_permlane32_swap(__float_as_uint(rm),__float_as_uint(rm),false,false); rm=__builtin_fmaxf(__uint_as_float(rr[0]),__uint_as_float(rr[1])); } \
      resc=false; \
      if(__builtin_expect(__any(rm>(float)THRL),0)){ const float dl=__builtin_fmaxf(rm,0.f); mhat+=dl; \
        _Pragma("unroll") for(int r=0;r<16;++r){C0[r]-=dl;C1[r]-=dl;} \
        const float f=__builtin_amdgcn_exp2f(-dl); l_reg*=f; if(hi==0)wsf[r32]=f; resc=true; } } \
    SBAR(); \
    GAPB(o[0]=__builtin_amdgcn_mfma_f32_32x32x16_bf16(PAF(0),VFR(0),o[0],0,0,0), C0,0); \
    GAPB(o[1]=__builtin_amdgcn_mfma_f32_32x32x16_bf16(PAF(0),VFR(4),o[1],0,0,0), C0,4); \
    KRD(GL,0); GAPB(o[0]=__builtin_amdgcn_mfma_f32_32x32x16_bf16(PAF(1),VFR(1),o[0],0,0,0), C0,8); \
    KRD(GL,1); GAPB(o[1]=__builtin_amdgcn_mfma_f32_32x32x16_bf16(PAF(1),VFR(5),o[1],0,0,0), C0,12); \
    KRD(GL,2); GAPB(o[0]=__builtin_amdgcn_mfma_f32_32x32x16_bf16(PAF(2),VFR(2),o[0],0,0,0), C1,0); \
    KRD(GL,3); GAPB(o[1]=__builtin_amdgcn_mfma_f32_32x32x16_bf16(PAF(2),VFR(6),o[1],0,0,0), C1,4); \
    GAPB(o[0]=__builtin_amdgcn_mfma_f32_32x32x16_bf16(PAF(3),VFR(3),o[0],0,0,0), C1,8); \
    GAPB(o[1]=__builtin_amdgcn_mfma_f32_32x32x16_bf16(PAF(3),VFR(7),o[1],0,0,0), C1,12); \
    }while(0)

#define ENDW(tt) do { if ((tt) + 3 < NT) { WAIT_BAR(2); } else if ((tt) + 2 < NT) { WAIT_BAR(1); } else { WAIT_BAR(0); } } while (0)
    int t = 1;
    for (; t + 1 < NT; t += 2) {
        STEP(pB0, pB1, pA0, pA1, t, (t + 3 < NT), (t + 1 < NT), (t + 1 < NT));       ENDW(t);     RESC(); ROT();
        STEP(pA0, pA1, pB0, pB1, t + 1, (t + 4 < NT), (t + 2 < NT), (t + 2 < NT));   ENDW(t + 1); RESC(); ROT();
    }
    STEP(pB0, pB1, pA0, pA1, NT - 1, false, false, false); RESC();
    { float sacc = pB0[0] + pB0[1];
#pragma unroll
      for (int r = 2; r < 16; ++r) sacc += pB0[r];
#pragma unroll
      for (int r = 0; r < 16; ++r) sacc += pB1[r];
      l_reg += sacc;
      pw0 = (v4u){PKW(pB0, 0), PKW(pB0, 2), PKW(pB0, 4), PKW(pB0, 6)}; pw1 = (v4u){PKW(pB0, 8), PKW(pB0, 10), PKW(pB0, 12), PKW(pB0, 14)};
      pw2 = (v4u){PKW(pB1, 0), PKW(pB1, 2), PKW(pB1, 4), PKW(pB1, 6)}; pw3 = (v4u){PKW(pB1, 8), PKW(pB1, 10), PKW(pB1, 12), PKW(pB1, 14)};
      SBAR(); pv(o, vb0 + sl_cur, PAF(0), PAF(1), PAF(2), PAF(3)); }
#undef PKW
#undef PAF
#undef VFR
#undef PIN
#undef MX3
#undef GAPA
#undef GAPB
#undef EX
#undef VRD
#undef KRD
#undef STEP
#undef ENDW
    { auto rr = __builtin_amdgcn_permlane32_swap(__float_as_uint(l_reg), __float_as_uint(l_reg), false, false); l_reg = __uint_as_float(rr[0]) + __uint_as_float(rr[1]); }
    if (hi == 0) wsf[32 + r32] = l_reg;
    asm volatile("s_waitcnt lgkmcnt(0)" ::: "memory");
    float rli[16];
#pragma unroll
    for (int r = 0; r < 16; ++r) rli[r] = __builtin_amdgcn_rcpf(wsf[32 + crow(r, hi)]);
    LAS bf16* stg = (LAS bf16*)(shm + F_OST) + wid * 2048;
#pragma unroll
    for (int r = 0; r < 16; ++r) { const int orow = crow(r, hi);
#pragma unroll
        for (int d0 = 0; d0 < 2; ++d0) stg[orow * 64 + d0 * 32 + r32] = (bf16)f2bf(o[d0][r] * rli[r]); }
    asm volatile("s_waitcnt lgkmcnt(0)" ::: "memory");
    bf16* Ow = F.Y() + (rowbase + q0 + wid * 32) * DM + Y_C + h * 64;
#pragma unroll
    for (int i = 0; i < 4; ++i) { const int row = i * 8 + (lane >> 3), ch = lane & 7; const v4u v = *(const LAS v4u*)(stg + row * 64 + ch * 8); *(v4u*)(Ow + (long)row * DM + ch * 8) = v; }
    asm volatile("s_waitcnt lgkmcnt(0)\n\ts_barrier" ::: "memory");
#undef DMA_K
#undef DMA_V
#undef PT
#undef INITC
#undef CMASK
#undef RESC
#undef ROT
}
#undef SBAR
#undef WAIT_BAR

constexpr int B_K = 0, B_V = 4 * SLOTB, B_WS = 8 * SLOTB, B_OST = B_WS + NWAVES * 256, B_TOK = B_OST + NWAVES * 4096, B_CNT = B_TOK + NWAVES * 256;
__device__ __forceinline__ void attn_blk_unit(const Frame& F0, int l, int b, int h, int n, bool causal, unsigned chunk, unsigned R) {
    const Frame F = F0.fresh();
    LAS char* shm = (LAS char*)F.lds;
    const int lane = F.lane, r32 = lane & 31, hi = lane >> 5, wid = F.wave;
    const long rowbase = (long)b * T;
    const bf16* Kh = F.Z() + rowbase * DIN + Z_CK + h * 64; const bf16* Vh = F.Z() + rowbase * DIN + Z_CV + h * 64;
    const unsigned lds0 = (unsigned)(uintptr_t)shm;
    LAS float* wsf = (LAS float*)(shm + B_WS) + wid * 64; LAS int* toks = (LAS int*)(shm + B_TOK) + wid * 64; LAS unsigned* cnt = (LAS unsigned*)(shm + B_CNT);
    const unsigned koff = (unsigned)(lane * DIN + wid * 8) * 2u, voff = (unsigned)((16 * (wid & 3) + (lane >> 2)) * DIN + (wid >> 2) * 32 + (lane & 3) * 8) * 2u;
    const unsigned kdst = lds0 + B_K + wid * 1024, vdst = lds0 + B_V + wid * 1024;
    const size_t list = (size_t)(b * 8 + h) * 32 + n;
    __syncthreads();
#pragma unroll
    for (int ti = 0; ti < 4; ++ti) { glds16s(Kh + (long)(4 * n + ti) * 64 * DIN, koff, (unsigned)__builtin_amdgcn_readfirstlane(kdst + ti * SLOTB)); glds16s(Vh + (long)(4 * n + ti) * 64 * DIN, voff, (unsigned)__builtin_amdgcn_readfirstlane(vdst + ti * SLOTB)); }
    if (!causal && F.tid < 32) cnt[F.tid] = (F.tid > n) ? F.CNT()[list * 32 + F.tid] : 0u;
    asm volatile("s_waitcnt vmcnt(0) lgkmcnt(0)" ::: "memory");
    __syncthreads();
    const int vb0 = (int)(lds0 + B_V) + ((lane >> 4) & 1) * 32 + (lane & 3) * 8 + (4 * hi + ((lane & 15) >> 2)) * 64;
    const lds_cptr kp0 = (lds_cptr)shm + B_K + hi * 1024 + r32 * 16;
    const float beta = __uint_as_float((unsigned)__builtin_amdgcn_readfirstlane((int)__float_as_uint(exp2f(-(float)(h + 1)) * LOG2E)));
    const int qrel = wid * 32 + r32;
    for (int k = 0; k < (causal ? 1 : 2); ++k) {
        int t, slot; bool valid = true;
        if (causal) { t = 256 * n + qrel; slot = 0; }
        else { const unsigned sg = chunk * 16u + (unsigned)(wid * 2 + k); if (sg * 32u >= R) break;
            unsigned s = sg * 32u + (unsigned)r32; valid = s < R; if (!valid) s = R - 1u;
            int j = n + 1; unsigned run = 0u; while (j < 31 && s >= run + cnt[j]) { run += cnt[j]; ++j; }
            t = 256 * j + (int)F.LIST()[(list * 32 + j) * 256 + (s - run)];
            const unsigned selm = F.SEL()[(size_t)(rowbase + t) * 8 + h]; slot = 1 + __builtin_popcount(selm & ((1u << n) - 1u)); }
        const bf16* Qp = F.Z() + (rowbase + t) * DIN + Z_CQ + h * 64 + hi * 8;
        bf16x8 qr[4];
#pragma unroll
        for (int d0 = 0; d0 < 4; ++d0) qr[d0] = *(const bf16x8*)(Qp + d0 * 16);
        const float qoff = (float)(256 * n + 4 * hi - t);
        const int tlim = causal ? ((wid * 32 + 31) >> 6) : 3;
        float mhat = 0.f, l_reg = 0.f; f32x16 o[2];
#pragma unroll
        for (int r = 0; r < 16; ++r) { o[0][r] = 0.f; o[1][r] = 0.f; }
        bool first = true;
        for (int ti = 0; ti <= tlim; ++ti) {
            const float ct = __builtin_fmaf(beta, (float)(64 * ti) + qoff, -mhat);
            f32x16 p0, p1;
#pragma unroll
            for (int r = 0; r < 16; ++r) { const float cr = (float)((r & 3) + 8 * (r >> 2)); p0[r] = __builtin_fmaf(beta, cr, ct); p1[r] = __builtin_fmaf(beta, cr + 32.f, ct); }
            const lds_cptr kb = kp0 + ti * SLOTB;
#pragma unroll
            for (int d0 = 0; d0 < 4; ++d0) { const bf16x8 b0 = *(const LAS bf16x8*)(kb + d0 * 2048), b1 = *(const LAS bf16x8*)(kb + d0 * 2048 + 512);
                p0 = __builtin_amdgcn_mfma_f32_32x32x16_bf16(b0, qr[d0], p0, 0, 0, 0); p1 = __builtin_amdgcn_mfma_f32_32x32x16_bf16(b1, qr[d0], p1, 0, 0, 0); }
            if (causal) { const int kb_ = 64 * ti + 4 * hi;
#pragma unroll
                for (int r = 0; r < 16; ++r) { const int kv = kb_ + (r & 3) + 8 * (r >> 2); if (kv > qrel) p0[r] = -INFINITY; if (kv + 32 > qrel) p1[r] = -INFINITY; } }
            const float rm = rowmax(p0, p1);
            bool resc = false;
            if (first || __any(rm > 0.f)) {
                const float dl = first ? rm : fmaxf(rm, 0.f); mhat += dl;
#pragma unroll
                for (int r = 0; r < 16; ++r) { p0[r] -= dl; p1[r] -= dl; }
                if (!first) { const float f = __builtin_amdgcn_exp2f(-dl); l_reg *= f; if (hi == 0) wsf[r32] = f; resc = true; }
            }
            if (resc) {
#pragma unroll
                for (int d_ = 0; d_ < 2; ++d_)
#pragma unroll
                    for (int r = 0; r < 16; ++r) o[d_][r] *= wsf[crow(r, hi)];
            }
            float sacc = 0.f;
#pragma unroll
            for (int r = 0; r < 16; ++r) { p0[r] = __builtin_amdgcn_exp2f(p0[r]); p1[r] = __builtin_amdgcn_exp2f(p1[r]); sacc += p0[r] + p1[r]; }
            l_reg += sacc;
            v4u pw0, pw1, pw2, pw3;
#define PKW(P, B) cvtpk_s(P[B], P[B + 1])
            pw0 = (v4u){PKW(p0, 0), PKW(p0, 2), PKW(p0, 4), PKW(p0, 6)}; pw1 = (v4u){PKW(p0, 8), PKW(p0, 10), PKW(p0, 12), PKW(p0, 14)};
            pw2 = (v4u){PKW(p1, 0), PKW(p1, 2), PKW(p1, 4), PKW(p1, 6)}; pw3 = (v4u){PKW(p1, 8), PKW(p1, 10), PKW(p1, 12), PKW(p1, 14)};
#undef PKW
            __builtin_amdgcn_sched_barrier(0);
            pv(o, vb0 + ti * SLOTB, __builtin_bit_cast(bf16x8, pw0), __builtin_bit_cast(bf16x8, pw1), __builtin_bit_cast(bf16x8, pw2), __builtin_bit_cast(bf16x8, pw3));
            first = false;
        }
        { auto rr = __builtin_amdgcn_permlane32_swap(__float_as_uint(l_reg), __float_as_uint(l_reg), false, false); l_reg = __uint_as_float(rr[0]) + __uint_as_float(rr[1]); }
        if (hi == 0) { wsf[32 + r32] = l_reg; toks[r32] = valid ? t : -1; toks[32 + r32] = slot;
            if (valid) { typedef float f32x2v __attribute__((ext_vector_type(2))); *(f32x2v*)(F.PML() + (((size_t)(rowbase + t) * 8 + h) * 4 + slot) * 2) = (f32x2v){mhat, l_reg}; } }
        float rli[16];
#pragma unroll
        for (int r = 0; r < 16; ++r) rli[r] = __builtin_amdgcn_rcpf(wsf[32 + crow(r, hi)]);
        LAS bf16* stg = (LAS bf16*)(shm + B_OST) + wid * 2048;
#pragma unroll
        for (int r = 0; r < 16; ++r) { const int orow = crow(r, hi);
#pragma unroll
            for (int d0 = 0; d0 < 2; ++d0) stg[orow * 64 + d0 * 32 + r32] = (bf16)f2bf(o[d0][r] * rli[r]); }
#pragma unroll
        for (int i = 0; i < 4; ++i) { const int row = i * 8 + (lane >> 3), ch = lane & 7; const v4u v = *(const LAS v4u*)(stg + row * 64 + ch * 8); const int tk = toks[row], sl = toks[32 + row];
            if (tk >= 0) *(v4u*)(F.PO(l, sl) + ((size_t)(rowbase + tk) * 8 + h) * 64 + ch * 8) = v; }
    }
}
__device__ __forceinline__ void attn_sparse_phase(const Frame& F0, int l) {
    const Frame F = F0.fresh();
    LAS unsigned* Tpre = (LAS unsigned*)(F.lds + LDSCTL_OFF + 1024);
    LAS unsigned* TR = Tpre + 520; LAS unsigned* Tw = TR + 512; LAS unsigned* Tq = Tw + 16;
    __syncthreads();
    { const int li = F.tid, n = li >> 4, bh = li & 15; const unsigned* cp = F.CNT() + ((size_t)bh * 32 + n) * 32; unsigned R = 0u;
      for (int j = n + 1; j < 32; ++j) R += cp[j];
      const unsigned nch = (R + 511u) >> 9; unsigned v = nch;
#pragma unroll
      for (int o_ = 1; o_ < 64; o_ <<= 1) { const unsigned t_ = (unsigned)__shfl_up((int)v, o_); if (F.lane >= o_) v += t_; }
      TR[li] = R; if (F.lane == 63) Tw[F.wave] = v;
      __syncthreads();
      unsigned base = 0u; for (int w = 0; w < F.wave; ++w) base += Tw[w];
      Tpre[li] = base + v - nch; if (li == 511) Tpre[512] = base + v; }
    __syncthreads();
    const unsigned Usp = Tpre[512], U = Usp + 512u;
    unsigned* ctr = (unsigned*)(F.ws + WS_CTL) + CW_QCTR + l * 64;
    for (;;) {
        __syncthreads();
        if (F.tid == 0) *Tq = __hip_atomic_fetch_add(ctr, 1u, __ATOMIC_RELAXED, __HIP_MEMORY_SCOPE_AGENT);
        __syncthreads();
        const unsigned u = (unsigned)__builtin_amdgcn_readfirstlane((int)*Tq);
        if (u >= U) break;
        if (u < Usp) { int lo = 0, hi_ = 511;
            while (lo < hi_) { const int mid = (lo + hi_ + 1) >> 1; if (Tpre[mid] <= u) lo = mid; else hi_ = mid - 1; }
            const int li = lo, n = li >> 4, bh = li & 15; attn_blk_unit(F, l, bh >> 3, bh & 7, n, false, u - Tpre[li], TR[li]); }
        else { const unsigned v = u - Usp; const int bh = (int)(v & 15u), j = (int)(v >> 4); attn_blk_unit(F, l, bh >> 3, bh & 7, j, true, 0u, 256u); }
    }
}
__device__ __forceinline__ void combine_rows(const Frame& F, int l) {
    const int gw = F.vcu * NWAVES + F.wave, NGW = F.G * NWAVES, h = F.lane >> 3, c8 = (F.lane & 7) * 8;
    typedef float f32x2v __attribute__((ext_vector_type(2)));
    for (int m = gw; m < M; m += NGW) {
        const unsigned selm = F.SEL()[(size_t)m * 8 + h]; const int ns = 1 + __builtin_popcount(selm);
        f32x2v ml[4]; v4u ov[4]; float mx = -INFINITY;
#pragma unroll
        for (int i = 0; i < 4; ++i) { ml[i] = (f32x2v){-INFINITY, 0.f}; ov[i] = (v4u){0u, 0u, 0u, 0u};
            if (i < ns) { ml[i] = *(const f32x2v*)(F.PML() + (((size_t)m * 8 + h) * 4 + i) * 2); ov[i] = *(const v4u*)(F.PO(l, i) + ((size_t)m * 8 + h) * 64 + c8); mx = fmaxf(mx, ml[i][0]); } }
        float acc[8], L = 0.f;
#pragma unroll
        for (int e = 0; e < 8; ++e) acc[e] = 0.f;
#pragma unroll
        for (int i = 0; i < 4; ++i) { const float w = (i < ns) ? __builtin_amdgcn_exp2f(ml[i][0] - mx) * ml[i][1] : 0.f; float o8[8]; unpack8(ov[i], o8); L += w;
#pragma unroll
            for (int e = 0; e < 8; ++e) acc[e] += w * o8[e]; }
        const float rl = __builtin_amdgcn_rcpf(L); float s = 0.f;
#pragma unroll
        for (int e = 0; e < 8; ++e) { acc[e] *= rl; s += acc[e] * acc[e]; }
        s = wave_sum(s); const float rs = rsqrtf(s * (1.f / 512.f) + EPS);
#pragma unroll
        for (int e = 0; e < 8; ++e) acc[e] *= rs;
        *(v4u*)(F.Y() + (size_t)m * DM + Y_C + h * 64 + c8) = pack8(acc);
    }
}
}

__device__ __forceinline__ void ycnorm_rows(const Frame& F) {
    const int gw = F.vcu * NWAVES + F.wave, NGW = F.G * NWAVES;
    for (int m = gw; m < M; m += NGW) { bf16* p = F.Y() + (size_t)m * DM + Y_C + F.lane * 8; float v[8]; unpack8(*(const v4u*)p, v); float s = 0.f;
#pragma unroll
        for (int j = 0; j < 8; ++j) s += v[j] * v[j];
        s = wave_sum(s); const float rs = rsqrtf(s * (1.f / 512.f) + EPS);
#pragma unroll
        for (int j = 0; j < 8; ++j) v[j] *= rs;
        *(v4u*)p = pack8(v); }
}
__device__ __forceinline__ void final_norm_rows(const Frame& F) {
    const int gw = F.vcu * NWAVES + F.wave, NGW = F.G * NWAVES;
    for (int m = gw; m < M; m += NGW) { GAS f32x4* xr = (GAS f32x4*)(F.out + (size_t)m * DM) + F.lane; const f32x4 s4 = *(const f32x4*)(F.SSQ() + (size_t)m * 4);
        const float rs = rsqrtf(((s4[0] + s4[1]) + (s4[2] + s4[3])) * (1.f / DM) + EPS);
#pragma unroll
        for (int j = 0; j < 4; ++j) { const f32x4 g = *((const f32x4*)F.norm_final() + F.lane + 64 * j); xr[64 * j] = xr[64 * j] * rs * g; } }
}

struct Args { const float* in[19]; float* out; unsigned char* ws; int ph_lo, ph_hi, use_bar, pad; };
__global__ void __launch_bounds__(NWAVES * 64, 2) mk_fwd(Args args) {
    __shared__ __attribute__((aligned(16))) unsigned char lds[LDS_BYTES];
    Frame F;
    F.lds = (LAS unsigned char*)lds;
    F.tid = threadIdx.x; F.lane = F.tid & 63; F.wave = __builtin_amdgcn_readfirstlane(F.tid >> 6);
    F.G = gridDim.x; { const int bx = blockIdx.x; F.vcu = (F.G % 8 == 0) ? (bx % 8) * (F.G / 8) + bx / 8 : bx; }
    const int vcu0 = F.vcu; const int wave0 = __builtin_amdgcn_readfirstlane((int)threadIdx.x >> 6);
    F.ka = (const unsigned char*)__builtin_amdgcn_kernarg_segment_ptr(); F.ws = args.ws; F.out = args.out;
    unsigned char* ws = args.ws;
    for (int u = F.tid; u < (LDS_BYTES - LDSCTL_OFF) / 4; u += NWAVES * 64) ((LAS unsigned*)(F.lds + LDSCTL_OFF))[u] = 0u;
    __syncthreads();
    XcdBarrier bar; bar.bar = (unsigned*)(ws + WS_CTL) + CW_BAR; bar.x = 0; bar.st = nullptr;
    if (args.use_bar) bar = xcd_barrier_post((unsigned*)(ws + WS_CTL) + CW_BAR, (volatile LAS unsigned*)(F.lds + MISC_OFF) + 8);

    bool dup_done = false; (void)dup_done;
    for (int ph = args.ph_lo; ph < args.ph_hi; ++ph) {
        {
            int w_i = wave0; asm volatile("" : "+s"(w_i)); int l_i = (int)__builtin_amdgcn_mbcnt_hi(~0u, __builtin_amdgcn_mbcnt_lo(~0u, 0u)); asm volatile("" : "+v"(l_i));
            F.wave = w_i; F.lane = l_i; F.tid = w_i * 64 + l_i;
            int v_ = vcu0; asm volatile("" : "+s"(v_)); F.vcu = v_;
            unsigned char* w_ = args.ws; asm volatile("" : "+s"(w_)); F.ws = w_;
            float* o_ = args.out; asm volatile("" : "+s"(o_)); F.out = o_;
        }
        const int l = (ph - 1) >> 3, k = (ph == 0) ? -1 : (ph == NPH - 1 ? 8 : ((ph - 1) & 7));
        if (k == -1) {
            p0_prologue(F);
        } else if (k == 0) {
            pg8::Gemm g{F.XB(), F.WIN(l), M, DIN, DM}; pg8::StaticOrder S; S.init(M, DIN, F.G, (int)blockIdx.x);
            pg8::EpiScale<0> E{F.Z(), DIN, F.SSQ(), 1.f / DM, EPS, Z_CQ, Z_CK, C2};
            pg8::gemm_phase<pg8::EpiScale<0>, pg8::StaticOrder, true, true>(F.lds, g, S, E, F.tid);
        } else if (k == 1) {
            for (int it = F.vcu; it < 1024 + 512 + 256; it += F.G) {
                if (it < 1024) hg_unit(F, l, it, false);
                else if (it < 1536) lru_unit(F, l, it - 1024, false);
                else kmean_unit(F, it - 1536);
            }
        } else if (k == 2) {
            for (int it = F.vcu; it < 256 + 512 + 16; it += F.G) {
                if (it < 256) select_unit(F, it);
                else if (it < 768) hg_scan_item(F, it - 256);
                else lru_scan_item(F, it - 768);
            }
        } else if (k == 3) {
            moba::attn_sparse_phase(F, l);
            for (int it = F.vcu; it < 1024 + 512; it += F.G) {
                if (it < 1024) hg_unit(F, l, it, true); else lru_unit(F, l, it - 1024, true);
            }
        } else if (k == 4) {
#if defined(DBG_REP4)
            if (DBG_REP4 == 2) for (int it = F.vcu; it < 1024; it += F.G) hg_unit(F, l, it, true);
            if (DBG_REP4 == 3) for (int it = F.vcu; it < 512; it += F.G) lru_unit(F, l, it, true);
            __syncthreads();
#endif
            moba::combine_rows(F, l);
        } else if (k == 5) {
            pg8::Gemm g{F.Y(), F.WOUT(l), M, DM, DM}; pg8::StaticOrder S; S.init(M, DM, F.G, (int)blockIdx.x);
            pg8::EpiRes E{l == 0 ? F.x() : F.out, F.out, F.XB(), F.SSQ(), DM};
            pg8::gemm_phase<pg8::EpiRes, pg8::StaticOrder, false, true>(F.lds, g, S, E, F.tid);
        } else if (k == 6) {
            pg8::Gemm g{F.XB(), F.W1(l), M, FF, DM}; pg8::StaticOrder S; S.init(M, FF, F.G, (int)blockIdx.x);
            pg8::EpiScale<1> E{F.H(), FF, F.SSQ(), 1.f / DM, EPS, 0, 0, 1.f};
            pg8::gemm_phase<pg8::EpiScale<1>, pg8::StaticOrder, true, true>(F.lds, g, S, E, F.tid);
        } else if (k == 7) {
            pg8::Gemm g{F.H(), F.W2(l), M, DM, FF}; pg8::StaticOrder S; S.init(M, DM, F.G, (int)blockIdx.x);
            pg8::EpiRes E{F.out, F.out, F.XB(), F.SSQ(), DM};
            pg8::gemm_phase<pg8::EpiRes, pg8::StaticOrder, false, true>(F.lds, g, S, E, F.tid);
        } else {
            final_norm_rows(F);
        }
        if (ph + 1 < args.ph_hi) xcd_barrier(bar);
#if defined(DBG_DUP)
        if (k == DBG_DUP && !dup_done) { dup_done = true; --ph; } else dup_done = false;
#endif
    }
}


#ifndef DBG_STOP
#define DBG_STOP 0
#endif
#if DBG_STOP
__global__ void dbg_dump(float* out, const unsigned char* ws, int keep_out) {
    const size_t n = (size_t)M * DM;
    for (size_t i = (size_t)blockIdx.x * blockDim.x + threadIdx.x; i < n; i += (size_t)gridDim.x * blockDim.x) {
        float v = 0.f; if (keep_out) { float t = out[i]; v = (t == t && fabsf(t) < 1e30f) ? t : 1e21f; }
        const bf16* big = (const bf16*)(ws + WS_Z);
        for (int q = 0; q < 4; ++q) { float t = bf1(big[i + (size_t)q * n]); const int cc = (int)(i % 1024); const float sen = q < 3 ? 1e9f : (cc < 256 ? 1e12f : (cc < 512 ? 1e15f : 1e18f)); v += (t == t && fabsf(t) < 1e30f) ? t : sen; }
        const float* sm = (const float*)(ws + 1 * MiB); { const size_t si = i % (4 * MiB / 4); float t = (si >= 128 * 1024 && si < 256 * 1024) ? 0.f : sm[si]; v += (t == t && fabsf(t) < 1e30f) ? t : 1e12f; }
        const float* hs = (const float*)(ws + WS_HGS); { float t = hs[i % (16 * MiB / 4)]; v += (t == t && fabsf(t) < 1e30f) ? t : 1e15f; }
        const bf16* xb = (const bf16*)(ws + WS_XB); { float t = bf1(xb[i]); v += (t == t && fabsf(t) < 1e30f) ? t : 1e18f; }
        out[i] = v;
    }
}
#endif
extern "C" void kernel_launch(void* const* d_in, const int* in_sizes, int n_in, void* d_out, int out_size, void* d_ws, size_t ws_size, hipStream_t stream) {
    if (n_in != 19 || out_size != M * DM || ws_size < WS_END) { fprintf(stderr, "kernel_launch: unexpected shapes (n_in %d, out %d, ws %zu)\n", n_in, out_size, ws_size); return; }
    const int grid = 256;
    (void)hipMemsetAsync((char*)d_ws + WS_CTL, 0, CTL_ZERO_BYTES, stream);
    Args a{};
    for (int i = 0; i < 19; ++i) a.in[i] = (const float*)d_in[i];
    a.out = (float*)d_out; a.ws = (unsigned char*)d_ws;
#if MK_ONE_LAUNCH
    a.ph_lo = 0; a.ph_hi = NPH; a.use_bar = 1;
    hipLaunchKernelGGL(mk_fwd, dim3(grid), dim3(NWAVES * 64), 0, stream, a);
#else
#if DBG_STOP
    const int nph = DBG_STOP;
#else
    const int nph = NPH;
#endif
    for (int ph = 0; ph < nph; ++ph) { a.ph_lo = ph; a.ph_hi = ph + 1; a.use_bar = 0; hipLaunchKernelGGL(mk_fwd, dim3(grid), dim3(NWAVES * 64), 0, stream, a); }
#if DBG_STOP
    hipLaunchKernelGGL(dbg_dump, dim3(2048), dim3(256), 0, stream, (float*)d_out, (const unsigned char*)d_ws, (int)(DBG_STOP >= 7));
#endif
#endif
}
```
